# Optimizing an MI355X kernel written in HIP

```python
import math
import numpy as np
import jax
import jax.numpy as jnp
from jax import lax

D_MODEL = 1024
BATCH = 4
SEQ = 8192
DEPTH = 2

GRID_W = 64
CTX_LEN = 256
WIN_HEADS = 8
WIN_KV_HEADS = 2
WIN_HEAD_DIM = 64
WINDOW = 128
BLOCK = 128
HG_HEADS = 4
HG_KEY_DIM = 64
HG_VAL_DIM = 64
CHUNK = 64
DIFF_HEADS = 4
DIFF_QK_DIM = 32
DIFF_V_DIM = 64
MIX_WIDTH = WIN_HEADS * WIN_HEAD_DIM + HG_HEADS * HG_VAL_DIM + DIFF_HEADS * DIFF_V_DIM
D_FF = 11 * D_MODEL // 4
CONV_WIDTH = 3
ROPE_BASE = 10000.0
EPS = 1e-6
SPLIT_SIZES = (
    WIN_HEADS * WIN_HEAD_DIM, WIN_KV_HEADS * WIN_HEAD_DIM, WIN_KV_HEADS * WIN_HEAD_DIM,
    HG_HEADS * HG_KEY_DIM, HG_HEADS * HG_KEY_DIM,
    HG_HEADS * HG_KEY_DIM, HG_HEADS * HG_KEY_DIM,
    HG_HEADS * HG_VAL_DIM, HG_HEADS * HG_VAL_DIM,
    DIFF_HEADS * 2 * DIFF_QK_DIM, DIFF_HEADS * 2 * DIFF_QK_DIM, DIFF_HEADS * DIFF_V_DIM,
)
IN_WIDTH = sum(SPLIT_SIZES)

kernel_name = 'hymba_style_hybrid_diffusion_trunk'

F32 = jnp.float32


def rms_norm(x, g):
    xf = x.astype(F32)
    y = xf * lax.rsqrt(jnp.mean(xf * xf, axis=-1, keepdims=True) + EPS)
    return (y * g.astype(F32)).astype(x.dtype)


def split_columns(p):
    idx = np.cumsum(SPLIT_SIZES)[:-1].tolist()
    return jnp.split(p, idx, axis=-1)


def adaln(vec, w, b):
    m = jax.nn.silu(vec) @ w + b
    return [t.reshape(-1, 1, D_MODEL) for t in jnp.split(m, 6, axis=-1)]


def axial_rope_tables(L, dim):
    rows = L // GRID_W
    row = jnp.repeat(jnp.arange(rows, dtype=F32), GRID_W)
    col = jnp.tile(jnp.arange(GRID_W, dtype=F32), rows)
    axis_dim = dim // 2
    n = axis_dim // 2
    inv = jnp.power(ROPE_BASE, -jnp.arange(n, dtype=F32) * 2.0 / axis_dim)
    ar = row[:, None] * inv[None, :]
    ac = col[:, None] * inv[None, :]
    return (jnp.cos(ar), jnp.sin(ar), jnp.cos(ac), jnp.sin(ac))


def _rotate_half(x, cos, sin):
    x1, x2 = jnp.split(x, 2, axis=-1)
    return jnp.concatenate([x1 * cos - x2 * sin, x1 * sin + x2 * cos], axis=-1)


def apply_axial_rope(x, tables):
    cos_r, sin_r, cos_c, sin_c = tables
    shape = (x.shape[1],) + (1,) * (x.ndim - 3) + (cos_r.shape[-1],)
    xr, xcol = jnp.split(x.astype(F32), 2, axis=-1)
    out = jnp.concatenate([
        _rotate_half(xr, cos_r.reshape(shape), sin_r.reshape(shape)),
        _rotate_half(xcol, cos_c.reshape(shape), sin_c.reshape(shape))], axis=-1)
    return out.astype(x.dtype)


def softmax_with_sink(s, sink):
    m = jnp.maximum(jnp.max(s, axis=-1, keepdims=True), sink)
    e = jnp.exp(s - m)
    return e / (jnp.sum(e, axis=-1, keepdims=True) + jnp.exp(sink - m))


def window_gqa_latent(q, k, v, kc, vc, sink):
    B, L, H, d = q.shape
    G = H // WIN_KV_HEADS
    nb = L // BLOCK
    qg = q.reshape(B, L, WIN_KV_HEADS, G, d)
    pad = ((0, 0), (BLOCK, BLOCK), (0, 0), (0, 0))
    kp = jnp.pad(k, pad)
    vp = jnp.pad(v, pad)
    sink = sink.astype(F32).reshape(1, WIN_KV_HEADS, G, 1, 1)
    scale = d ** -0.5

    def block(j):
        start = j * BLOCK
        qb = lax.dynamic_slice_in_dim(qg, start, BLOCK, axis=1)
        kb = lax.dynamic_slice_in_dim(kp, start, 3 * BLOCK, axis=1)
        vb = lax.dynamic_slice_in_dim(vp, start, 3 * BLOCK, axis=1)
        qpos = start + jnp.arange(BLOCK)
        kpos = start - BLOCK + jnp.arange(3 * BLOCK)
        band = (jnp.abs(qpos[:, None] - kpos[None, :]) <= WINDOW) & (kpos >= 0)[None, :] & (kpos < L)[None, :]
        s_loc = jnp.einsum('bqkgd,bskd->bkgqs', qb, kb).astype(F32) * scale
        s_loc = jnp.where(band, s_loc, -jnp.inf)
        s_ctx = jnp.einsum('bqkgd,bskd->bkgqs', qb, kc).astype(F32) * scale
        p = softmax_with_sink(jnp.concatenate([s_loc, s_ctx], axis=-1), sink).astype(v.dtype)
        o = (jnp.einsum('bkgqs,bskd->bqkgd', p[..., :3 * BLOCK], vb)
             + jnp.einsum('bkgqs,bskd->bqkgd', p[..., 3 * BLOCK:], vc))
        return o.reshape(B, BLOCK, H * d)

    o = lax.map(block, jnp.arange(nb))
    return o.transpose(1, 0, 2, 3).reshape(B, L, H * d)


def gqa_context(qc, kc, vc, sink):
    B, Lc, H, d = qc.shape
    G = H // WIN_KV_HEADS
    qg = qc.reshape(B, Lc, WIN_KV_HEADS, G, d)
    s = jnp.einsum('bqkgd,bskd->bkgqs', qg, kc).astype(F32) * d ** -0.5
    p = softmax_with_sink(s, sink.astype(F32).reshape(1, WIN_KV_HEADS, G, 1, 1)).astype(vc.dtype)
    return jnp.einsum('bkgqs,bskd->bqkgd', p, vc).reshape(B, Lc, H * d)


def hgrn2_lower_bounds(raw):
    p = jax.nn.softmax(raw.astype(F32), axis=0)
    return jnp.cumsum(p, axis=0) - p[0]


def hgrn2_gates(pq, pf, lb):
    B, L, _ = pq.shape
    q = pq.reshape(B, L, HG_HEADS, HG_KEY_DIM).astype(F32)
    lb = lb.reshape(HG_HEADS, HG_KEY_DIM)
    f = lb + (1.0 - lb) * jax.nn.sigmoid(pf.reshape(B, L, HG_HEADS, HG_KEY_DIM).astype(F32))
    return q, jnp.log(f), 1.0 - f


def hgrn2_chunk_scan(q, logf, k, v, s0, with_output):
    B, L, H, dk = q.shape
    dv = v.shape[-1]
    n = L // CHUNK

    def chunks(t):
        return t.reshape(B, n, CHUNK, H, t.shape[-1]).transpose(1, 0, 3, 2, 4)

    tri = jnp.tril(jnp.ones((CHUNK, CHUNK), dtype=bool))[None, None, :, :, None]

    def step(S, xs):
        qc, lfc, kc, vc = xs
        b = jnp.cumsum(lfc, axis=2)
        b_end = b[:, :, -1]
        S_new = (jnp.exp(b_end)[..., None] * S
                 + jnp.einsum('bhsk,bhsv->bhkv', kc * jnp.exp(b_end[:, :, None, :] - b), vc))
        if not with_output:
            return S_new, None
        rel = jnp.where(tri, b[:, :, :, None, :] - b[:, :, None, :, :], -jnp.inf)
        A = jnp.einsum('bhtk,bhsk,bhtsk->bhts', qc, kc, jnp.exp(rel))
        o = (jnp.einsum('bhts,bhsv->bhtv', A, vc)
             + jnp.einsum('bhtk,bhkv->bhtv', qc * jnp.exp(b), S))
        return S_new, o

    S, o = lax.scan(step, s0, (chunks(q), chunks(logf), chunks(k), chunks(v)))
    if not with_output:
        return S, None
    return S, o.transpose(1, 0, 3, 2, 4).reshape(B, L, H, dv)


def maybe_flip(t, rev):
    return jnp.flip(t, axis=1) if rev else t


def hgrn2_bidirectional(pl, pc, lb, need_ctx):
    B, L, _ = pl[4].shape
    Lc = pc[4].shape[1]
    il = pl[4].reshape(B, L, HG_HEADS, HG_VAL_DIM).astype(F32)
    ic = pc[4].reshape(B, Lc, HG_HEADS, HG_VAL_DIM).astype(F32)
    o_l = 0.0
    o_c = 0.0
    for d in range(2):
        rev = d == 1
        ql, lfl, kl = hgrn2_gates(pl[2 * d], pl[2 * d + 1], lb[d])
        qc, lfc, kc = hgrn2_gates(pc[2 * d], pc[2 * d + 1], lb[d])
        s0 = jnp.zeros((B, HG_HEADS, HG_KEY_DIM, HG_VAL_DIM), F32)
        s_ctx, oc = hgrn2_chunk_scan(maybe_flip(qc, rev), maybe_flip(lfc, rev), maybe_flip(kc, rev),
                                     maybe_flip(ic, rev), s0, need_ctx)
        _, ol = hgrn2_chunk_scan(maybe_flip(ql, rev), maybe_flip(lfl, rev), maybe_flip(kl, rev),
                                 maybe_flip(il, rev), s_ctx, True)
        o_l = o_l + maybe_flip(ol, rev)
        if need_ctx:
            o_c = o_c + maybe_flip(oc, rev)
    return o_l, (o_c if need_ctx else None)


def hgrn2_readout(o, g, og):
    B, L = o.shape[:2]
    gate = jax.nn.silu(g.reshape(B, L, HG_HEADS, HG_VAL_DIM).astype(F32))
    return (rms_norm(o, og) * gate).reshape(B, L, HG_HEADS * HG_VAL_DIM)


def diff_attn(q, k, v, lam):
    s = jnp.einsum('bqhcd,bshcd->bhcqs', q, k).astype(F32) * DIFF_QK_DIM ** -0.5
    p = jax.nn.softmax(s, axis=-1)
    a = (p[:, :, 0] - lam * p[:, :, 1]).astype(v.dtype)
    return jnp.einsum('bhqs,bshd->bqhd', a, v)


def diff_attn_latent(q, k_all, v_all, lam):
    B, L = q.shape[:2]
    nb = L // BLOCK

    def block(j):
        qb = lax.dynamic_slice_in_dim(q, j * BLOCK, BLOCK, axis=1)
        return diff_attn(qb, k_all, v_all, lam)

    o = lax.map(block, jnp.arange(nb))
    return o.transpose(1, 0, 2, 3, 4).reshape(B, L, DIFF_HEADS, DIFF_V_DIM)


def token_mixers(hl, hc, w_in, win_qg, win_kg, win_sink, lb, hg_og, diff_qg, diff_kg, diff_lam, diff_og,
                 lam_init, rope_a, rope_d, need_ctx):
    B, L, _ = hl.shape
    Lc = hc.shape[1]
    pl = split_columns(hl @ w_in)
    pc = split_columns(hc @ w_in)

    def a_qkv(p, n):
        q = rms_norm(p[0].reshape(B, n, WIN_HEADS, WIN_HEAD_DIM), win_qg)
        k = rms_norm(p[1].reshape(B, n, WIN_KV_HEADS, WIN_HEAD_DIM), win_kg)
        v = p[2].reshape(B, n, WIN_KV_HEADS, WIN_HEAD_DIM)
        return q, k, v

    qa, ka, va = a_qkv(pl, L)
    qa = apply_axial_rope(qa, rope_a)
    ka = apply_axial_rope(ka, rope_a)
    qac, kac, vac = a_qkv(pc, Lc)
    oa_l = window_gqa_latent(qa, ka, va, kac, vac, win_sink)

    ob_l, ob_c = hgrn2_bidirectional(pl[3:8], pc[3:8], lb, need_ctx)
    ob_l = hgrn2_readout(ob_l, pl[8], hg_og).astype(hl.dtype)

    lam_f = diff_lam.astype(F32)
    lam = jnp.exp(jnp.sum(lam_f[0] * lam_f[1])) - jnp.exp(jnp.sum(lam_f[2] * lam_f[3])) + lam_init

    def d_qkv(p, n):
        q = rms_norm(p[9].reshape(B, n, DIFF_HEADS, 2, DIFF_QK_DIM), diff_qg)
        k = rms_norm(p[10].reshape(B, n, DIFF_HEADS, 2, DIFF_QK_DIM), diff_kg)
        v = p[11].reshape(B, n, DIFF_HEADS, DIFF_V_DIM)
        return q, k, v

    qd, kd, vd = d_qkv(pl, L)
    qd = apply_axial_rope(qd, rope_d)
    kd = apply_axial_rope(kd, rope_d)
    qdc, kdc, vdc = d_qkv(pc, Lc)
    od_l = diff_attn_latent(qd, jnp.concatenate([kd, kdc], axis=1), jnp.concatenate([vd, vdc], axis=1), lam)
    od_l = (rms_norm(od_l, diff_og) * (1.0 - lam_init)).reshape(B, L, DIFF_HEADS * DIFF_V_DIM)

    out_l = jnp.concatenate([oa_l, ob_l, od_l.astype(hl.dtype)], axis=-1)
    if not need_ctx:
        return out_l, None

    oa_c = gqa_context(qac, kac, vac, win_sink)
    ob_c = hgrn2_readout(ob_c, pc[8], hg_og).astype(hc.dtype)
    od_c = (rms_norm(diff_attn(qdc, kdc, vdc, lam), diff_og) * (1.0 - lam_init)).reshape(B, Lc, -1)
    out_c = jnp.concatenate([oa_c, ob_c, od_c.astype(hc.dtype)], axis=-1)
    return out_l, out_c


def conv_ffn(h, w_up, conv_w, conv_b, w_down):
    u = h @ w_up
    L = u.shape[1]
    r = CONV_WIDTH // 2
    up = jnp.pad(u, ((0, 0), (r, r), (0, 0)))
    y = conv_b + up[:, 0:L] * conv_w[0]
    for j in range(1, CONV_WIDTH):
        y = y + up[:, j:j + L] * conv_w[j]
    a, val = jnp.split(y, 2, axis=-1)
    return (jax.nn.silu(a) * val) @ w_down


def setup_inputs(seed: int = 0) -> dict:
    key = jax.random.key(seed)
    ks = jax.random.split(key, 24)

    def nrm(k, shape, s):
        return jax.random.normal(k, shape, F32) * s

    D = D_MODEL
    return {
        'x': nrm(ks[0], (BATCH, SEQ, D), 1.0),
        'c': nrm(ks[1], (BATCH, D), 1.0),
        'ctx': nrm(ks[2], (BATCH, CTX_LEN, D), 1.0),
        'c_ctx': nrm(ks[3], (D,), 1.0),
        'w_mod': nrm(ks[4], (DEPTH, D, 6 * D), 0.5 * D ** -0.5),
        'b_mod': nrm(ks[5], (DEPTH, 6 * D), 0.02),
        'norm1_g': 1.0 + nrm(ks[6], (DEPTH, D), 0.05),
        'norm2_g': 1.0 + nrm(ks[7], (DEPTH, D), 0.05),
        'w_in': nrm(ks[8], (DEPTH, D, IN_WIDTH), D ** -0.5),
        'win_qnorm_g': 1.0 + nrm(ks[9], (DEPTH, WIN_HEAD_DIM), 0.05),
        'win_knorm_g': 1.0 + nrm(ks[10], (DEPTH, WIN_HEAD_DIM), 0.05),
        'win_sink': nrm(ks[11], (DEPTH, WIN_HEADS), 0.5),
        'hg_lower': nrm(ks[12], (DEPTH, 2, HG_HEADS * HG_KEY_DIM), 1.0),
        'hg_onorm_g': 1.0 + nrm(ks[13], (DEPTH, HG_VAL_DIM), 0.05),
        'diff_qnorm_g': 1.0 + nrm(ks[14], (DEPTH, DIFF_QK_DIM), 0.05),
        'diff_knorm_g': 1.0 + nrm(ks[15], (DEPTH, DIFF_QK_DIM), 0.05),
        'diff_lambda': nrm(ks[16], (DEPTH, 4, DIFF_QK_DIM), 0.1),
        'diff_onorm_g': 1.0 + nrm(ks[17], (DEPTH, DIFF_V_DIM), 0.05),
        'w_out': nrm(ks[18], (DEPTH, MIX_WIDTH, D), MIX_WIDTH ** -0.5),
        'w_up': nrm(ks[19], (DEPTH, D, 2 * D_FF), D ** -0.5),
        'conv_w': nrm(ks[20], (DEPTH, CONV_WIDTH, 2 * D_FF), CONV_WIDTH ** -0.5),
        'conv_b': nrm(ks[21], (DEPTH, 2 * D_FF), 0.02),
        'w_down': nrm(ks[22], (DEPTH, D_FF, D), D_FF ** -0.5),
    }


def reference(x, c, ctx, c_ctx, w_mod, b_mod, norm1_g, norm2_g, w_in, win_qnorm_g, win_knorm_g, win_sink,
              hg_lower, hg_onorm_g, diff_qnorm_g, diff_knorm_g, diff_lambda, diff_onorm_g, w_out,
              w_up, conv_w, conv_b, w_down):
    L = x.shape[1]
    rope_a = axial_rope_tables(L, WIN_HEAD_DIM)
    rope_d = axial_rope_tables(L, DIFF_QK_DIM)
    lower = hgrn2_lower_bounds(hg_lower)
    xl, xc = x, ctx
    for l in range(DEPTH):
        need_ctx = l < DEPTH - 1
        lam_init = 0.8 - 0.6 * math.exp(-0.3 * l)
        sh1, sc1, g1, sh2, sc2, g2 = adaln(c, w_mod[l], b_mod[l])
        csh1, csc1, cg1, csh2, csc2, cg2 = adaln(c_ctx, w_mod[l], b_mod[l])
        hl = rms_norm(xl, norm1_g[l]) * (1.0 + sc1) + sh1
        hc = rms_norm(xc, norm1_g[l]) * (1.0 + csc1) + csh1
        ol, oc = token_mixers(hl, hc, w_in[l], win_qnorm_g[l], win_knorm_g[l], win_sink[l], lower[l],
                              hg_onorm_g[l], diff_qnorm_g[l], diff_knorm_g[l], diff_lambda[l], diff_onorm_g[l],
                              lam_init, rope_a, rope_d, need_ctx)
        xl = xl + g1 * (ol @ w_out[l])
        hl = rms_norm(xl, norm2_g[l]) * (1.0 + sc2) + sh2
        xl = xl + g2 * conv_ffn(hl, w_up[l], conv_w[l], conv_b[l], w_down[l])
        if need_ctx:
            xc = xc + cg1 * (oc @ w_out[l])
            hc = rms_norm(xc, norm2_g[l]) * (1.0 + csc2) + csh2
            xc = xc + cg2 * conv_ffn(hc, w_up[l], conv_w[l], conv_b[l], w_down[l])
    return xl
```

```cpp
#include <hip/hip_runtime.h>
#include <hip/hip_cooperative_groups.h>
#include <cstdio>
#include <cstdint>
namespace cg = cooperative_groups;
#ifndef PROBE_DIFF2
#define PROBE_DIFF2 0
#endif
#ifndef PROBE_WIN2
#define PROBE_WIN2 0
#endif
#ifndef PROBE_SYNC2
#define PROBE_SYNC2 0
#endif
#ifndef PROBE_GEMM2
#define PROBE_GEMM2 0
#endif
#ifndef PROBE_HG2
#define PROBE_HG2 0
#endif
#ifndef PROBE_EW2
#define PROBE_EW2 0
#endif
#ifndef PROBE_P02
#define PROBE_P02 0
#endif
#ifndef PROBE_IN2
#define PROBE_IN2 0
#endif
#ifndef PROBE_UP2
#define PROBE_UP2 0
#endif
namespace pg8 {
#define PG8_LAS __attribute__((address_space(3)))
typedef unsigned short bf16_t;
typedef short bf16x8 __attribute__((ext_vector_type(8)));
typedef float f32x4 __attribute__((ext_vector_type(4)));
typedef unsigned u32x4 __attribute__((ext_vector_type(4)));
constexpr int BM = 256, BK = 64, HALF = 128, HTB = HALF * BK * 2  , STAGE_BYTES = 8 * HTB, NXCD = 8, WGM = 8;

__host__ __device__ __forceinline__ int lds_byte(int r, int c) { const int st = (r >> 4) * 2 + (c >> 5), rr = r & 15, cc = c & 31, ob = rr * 64 + cc * 2; return st * 1024 + (ob ^ (((ob >> 9) & 1) << 5)); }
__host__ __device__ __forceinline__ void stage_rc(int b, int& R, int& C) { const int st = b / 1024, sb = b % 1024, swz = sb ^ (((sb >> 9) & 1) << 5); R = (st >> 1) * 16 + swz / 64; C = (st & 1) * 32 + (swz % 64) / 2; }
__host__ __device__ __forceinline__ int perm32(int rho) { const int n = rho >> 4, i = rho & 15; return 8 * (i >> 2) + 4 * n + (i & 3); }

struct Unit { int pm, pn; };
struct Gemm { const bf16_t* A; const bf16_t* Bt; int M, N, K; };

struct StaticOrder {
    int nM, nN, nwg, G, c;
    __host__ __device__ void init(int M, int N, int G_, int c_) { nM = M / BM; nN = N / BM; nwg = nM * nN; G = G_; c = c_; }
    __host__ __device__ bool next(int i, Unit& u) const {
        const long L = (long)i * G + c; if (L >= nwg) return false;
        int wgid = (int)L; { const int q = nwg / NXCD, r = nwg % NXCD, xcd = wgid % NXCD, off = wgid / NXCD; wgid = (xcd < r ? xcd * (q + 1) : r * (q + 1) + (xcd - r) * q) + off; }
        const int nig = WGM * nN, gid = wgid / nig, fm = gid * WGM, gsz = (nM - fm) < WGM ? (nM - fm) : WGM;
        u.pm = fm + ((wgid % nig) % gsz); u.pn = (wgid % nig) / gsz; return true;
    }
    __device__ __forceinline__ void a_ready(const Unit&) const {}
    __device__ __forceinline__ void done(const Unit&) const {}
};

__device__ __forceinline__ unsigned cvt_pk_bf16(float lo, float hi) { unsigned r; asm volatile("v_cvt_pk_bf16_f32 %0, %1, %2" : "=v"(r) : "v"(lo), "v"(hi)); return r; }
typedef unsigned u32x2 __attribute__((ext_vector_type(2)));
struct EpiBf16 {
    static constexpr bool PERM = true, AFTER_DRAIN = false, APERM = false;
    bf16_t* O; int ldc;
    __device__ __forceinline__ void operator()(const f32x4 (&acc)[2][2][4][2], const Unit& u, int wr, int wc, int fr, int fq) const {
        const int row0 = u.pm * BM + wr * 64 + fr; const int col0 = u.pn * BM + wc * 32 + 8 * fq;
#pragma unroll
        for (int ai = 0; ai < 2; ++ai)
#pragma unroll
            for (int m = 0; m < 4; ++m) { bf16_t* rowp = O + (size_t)(row0 + ai * HALF + m * 16) * ldc + col0;
#pragma unroll
                for (int bj = 0; bj < 2; ++bj) { const f32x4 v0 = acc[ai][bj][m][0], v1 = acc[ai][bj][m][1];
                    u32x4 w; w.x = cvt_pk_bf16(v0[0], v0[1]); w.y = cvt_pk_bf16(v0[2], v0[3]); w.z = cvt_pk_bf16(v1[0], v1[1]); w.w = cvt_pk_bf16(v1[2], v1[3]);
                    *(u32x4*)(rowp + bj * HALF) = w; } }
    }
};
struct EpiResGate {
    static constexpr bool PERM = false, AFTER_DRAIN = false, APERM = false;
    const float* base_lat; const float* base_ctx; float* out_lat; float* out_ctx; const float* gate;
    __device__ __forceinline__ void operator()(const f32x4 (&acc)[2][2][4][2], const Unit& u, int wr, int wc, int fr, int fq) const {
        const bool isctx = u.pm >= 128;
        const int v = isctx ? 4 : (u.pm >> 5);
        const float* bp = isctx ? base_ctx - (size_t)32768 * 1024 : base_lat;
        float* op = isctx ? out_ctx - (size_t)32768 * 1024 : out_lat;
        const float* g = gate + v * 6144;
        const int row0 = u.pm * BM + wr * 64 + fr; const int col0 = u.pn * BM + wc * 32 + 4 * fq;
        f32x4 gv[2][2];
#pragma unroll
        for (int bj = 0; bj < 2; ++bj)
#pragma unroll
            for (int n = 0; n < 2; ++n) gv[bj][n] = *(const f32x4*)(g + col0 + bj * HALF + n * 16);
#pragma unroll
        for (int ai = 0; ai < 2; ++ai) {
            f32x4 bs[4][2][2];
#pragma unroll
            for (int m = 0; m < 4; ++m) { const size_t off = (size_t)(row0 + ai * HALF + m * 16) * 1024 + col0;
#pragma unroll
                for (int bj = 0; bj < 2; ++bj)
#pragma unroll
                    for (int n = 0; n < 2; ++n) bs[m][bj][n] = *(const f32x4*)(bp + off + bj * HALF + n * 16); }
#pragma unroll
            for (int m = 0; m < 4; ++m) { const size_t off = (size_t)(row0 + ai * HALF + m * 16) * 1024 + col0;
#pragma unroll
                for (int bj = 0; bj < 2; ++bj)
#pragma unroll
                    for (int n = 0; n < 2; ++n) *(f32x4*)(op + off + bj * HALF + n * 16) = bs[m][bj][n] + gv[bj][n] * acc[ai][bj][m][n]; }
            asm volatile("" ::: "memory");
        }
    }
};
__device__ __forceinline__ float dpp_ror1(float v) { return __builtin_bit_cast(float, __builtin_amdgcn_update_dpp(0, __builtin_bit_cast(int, v), 0x121, 0xF, 0xF, false)); }
__device__ __forceinline__ float dpp_ror15(float v) { return __builtin_bit_cast(float, __builtin_amdgcn_update_dpp(0, __builtin_bit_cast(int, v), 0x12F, 0xF, 0xF, false)); }
struct EpiConvGate {
    static constexpr bool PERM = true, AFTER_DRAIN = false, APERM = true;
    bf16_t* ACT; bf16_t* UB; const float* cw; const float* cb;
    __device__ __forceinline__ void operator()(const f32x4 (&acc)[2][2][4][2], const Unit& u, int wr, int wc, int fr, int fq) const {
        const int chb = u.pn * 128 + wc * 32 + 8 * fq;
        const bool f0 = fr == 0, f15 = fr == 15;
#pragma unroll
        for (int n = 0; n < 2; ++n) {
            const int ch = chb + 4 * n;
            const f32x4 w0a = *(const f32x4*)(cw + ch), w1a = *(const f32x4*)(cw + 5632 + ch), w2a = *(const f32x4*)(cw + 2 * 5632 + ch), ba = *(const f32x4*)(cb + ch);
            const f32x4 w0v = *(const f32x4*)(cw + 2816 + ch), w1v = *(const f32x4*)(cw + 5632 + 2816 + ch), w2v = *(const f32x4*)(cw + 2 * 5632 + 2816 + ch), bv = *(const f32x4*)(cb + 2816 + ch);
#pragma unroll
            for (int ai = 0; ai < 2; ++ai) {
                const int kb = u.pm * 4 + ai * 2 + wr;
                f32x4 pa0, pv0, na3, nv3;
#pragma unroll
                for (int e = 0; e < 4; ++e) { pa0[e] = dpp_ror1(acc[ai][0][3][n][e]); pv0[e] = dpp_ror1(acc[ai][1][3][n][e]); na3[e] = dpp_ror15(acc[ai][0][0][n][e]); nv3[e] = dpp_ror15(acc[ai][1][0][n][e]); }
#pragma unroll
                for (int m = 0; m < 4; ++m) {
                    const f32x4 ua = acc[ai][0][m][n], uv = acc[ai][1][m][n];
                    const f32x4 pa = (m > 0) ? acc[ai][0][m - 1][n] : pa0, na = (m < 3) ? acc[ai][0][m + 1][n] : na3;
                    const f32x4 pv = (m > 0) ? acc[ai][1][m - 1][n] : pv0, nv = (m < 3) ? acc[ai][1][m + 1][n] : nv3;
                    const f32x4 ya = ba + w0a * pa + w1a * ua + w2a * na, yv = bv + w0v * pv + w1v * uv + w2v * nv;
                    f32x4 o;
#pragma unroll
                    for (int e = 0; e < 4; ++e) o[e] = ya[e] * __builtin_amdgcn_rcpf(1.f + __builtin_amdgcn_exp2f(-1.4426950408889634f * ya[e])) * yv[e];
                    const int rowin = 4 * fr + m;
                    const bool deferred = (m == 0 && f0) || (m == 3 && f15);
                    if (!deferred) { u32x2 w; w.x = cvt_pk_bf16(o[0], o[1]); w.y = cvt_pk_bf16(o[2], o[3]); *(u32x2*)(ACT + (size_t)(kb * 64 + rowin) * 2816 + ch) = w; }
                    if ((f0 && m < 2) || (f15 && m >= 2)) { const int q = f0 ? m : m;
                        u32x2 wa, wv; wa.x = cvt_pk_bf16(ua[0], ua[1]); wa.y = cvt_pk_bf16(ua[2], ua[3]); wv.x = cvt_pk_bf16(uv[0], uv[1]); wv.y = cvt_pk_bf16(uv[2], uv[3]);
                        bf16_t* ub = UB + (size_t)((kb * 4 + q) * 2) * 2816 + ch; *(u32x2*)ub = wa; *(u32x2*)(ub + 2816) = wv; }
                }
            }
        }
    }
};
template <class Epi, class Sched, bool ALIGN_EPI = false, bool SP2 = false>
__device__ __forceinline__ void gemm_phase(PG8_LAS unsigned char* lds, const Gemm g, const Sched& S, const Epi& E, int tid_in) {
    int tid_ = tid_in; asm volatile("" : "+v"(tid_)); const int tid = tid_, wid = __builtin_amdgcn_readfirstlane(tid >> 6), lane = tid & 63, wr = wid >> 2, wc = wid & 3, fr = lane & 15, fq = lane >> 4;
    const int K = g.K, nt = K / BK;
    unsigned voffA[2], voffB[2];
#pragma unroll
    for (int i = 0; i < 2; ++i) { int R, C; stage_rc(tid * 16 + i * 8192, R, C); const int Rb = Epi::PERM ? ((R & ~31) + perm32(R & 31)) : R;
        const int Ra = Epi::APERM ? ((R & ~63) + 4 * (R & 15) + ((R & 63) >> 4)) : R;
        voffA[i] = (unsigned)(Ra * K + C) * 2u; voffB[i] = (unsigned)(Rb * K + C) * 2u; }
    const size_t kstep = (size_t)(BK * 2);
    const size_t hstep = (size_t)HALF * K * 2;
    const size_t tstep = 2 * hstep;
    const unsigned ldsw = (unsigned)wid * 1024u;
    const int aoff = lds_byte(wr * 64 + fr, fq * 8), boff = lds_byte(wc * 32 + fr, fq * 8);
#define PG8_SA(b, h) (((b) * 2 + (h)) * HTB)
#define PG8_SB(b, h) ((4 + (b) * 2 + (h)) * HTB)
#define PG8_STAGE(bufoff, gbase, voff) do { _Pragma("unroll") for (int _i = 0; _i < 2; ++_i) \
        __builtin_amdgcn_global_load_lds((const unsigned*)((const char*)(gbase) + (voff)[_i]), (PG8_LAS unsigned*)(lds + (bufoff) + ldsw + _i * 8192), 16, 0, 0); } while (0)
#define PG8_LDA(dst, b, h) do { _Pragma("unroll") for (int m = 0; m < 4; ++m) _Pragma("unroll") for (int k = 0; k < 2; ++k) dst[m][k] = *(const PG8_LAS bf16x8*)(lds + PG8_SA(b, h) + aoff + m * 2048 + k * 1024); } while (0)
#define PG8_LDB(dst, b, h) do { _Pragma("unroll") for (int n = 0; n < 2; ++n) _Pragma("unroll") for (int k = 0; k < 2; ++k) dst[n][k] = *(const PG8_LAS bf16x8*)(lds + PG8_SB(b, h) + boff + n * 2048 + k * 1024); } while (0)
#define PG8_MMA(ai, bj, At, Bt) do { __builtin_amdgcn_s_setprio(1); _Pragma("unroll") for (int m = 0; m < 4; ++m) _Pragma("unroll") for (int n = 0; n < 2; ++n) _Pragma("unroll") for (int k = 0; k < 2; ++k) \
        acc[ai][bj][m][n] = __builtin_amdgcn_mfma_f32_16x16x32_bf16(Bt[n][k], At[m][k], acc[ai][bj][m][n], 0, 0, 0); __builtin_amdgcn_s_setprio(0); } while (0)
#define PG8_WAIT_V(n) asm volatile("s_waitcnt vmcnt(" #n ")" ::: "memory")
#define PG8_WAIT_L(n) asm volatile("s_waitcnt lgkmcnt(" #n ")" ::: "memory")
#define PG8_BAR __builtin_amdgcn_s_barrier()
#define PG8_SCHED __builtin_amdgcn_sched_barrier(0)
    Unit cur, nxt; int ui = 0;
    if (!S.next(0, cur)) return;
    f32x4 acc[2][2][4][2];
#pragma unroll
    for (int a = 0; a < 2; ++a)
#pragma unroll
        for (int b = 0; b < 2; ++b)
#pragma unroll
            for (int m = 0; m < 4; ++m)
#pragma unroll
                for (int n = 0; n < 2; ++n) acc[a][b][m][n] = (f32x4){0.f, 0.f, 0.f, 0.f};
    bf16x8 At[4][2], B0[2][2], B1[2][2];
    const char* cA = (const char*)g.A + (size_t)cur.pm * tstep; const char* cB = (const char*)g.Bt + (size_t)cur.pn * tstep;
    S.a_ready(cur);
    if constexpr (SP2) {
        PG8_STAGE(PG8_SB(0, 0), cB, voffB); PG8_STAGE(PG8_SB(0, 1), cB + hstep, voffB); PG8_STAGE(PG8_SA(0, 0), cA, voffA); PG8_STAGE(PG8_SA(0, 1), cA + hstep, voffA);
        if (wr == 1) PG8_BAR;
        PG8_WAIT_V(2); PG8_BAR;
        PG8_STAGE(PG8_SB(1, 0), cB + kstep, voffB); PG8_STAGE(PG8_SA(1, 0), cA + kstep, voffA); PG8_STAGE(PG8_SB(1, 1), cB + hstep + kstep, voffB);
        PG8_WAIT_V(6); PG8_BAR;
    } else {
        PG8_STAGE(PG8_SB(0, 0), cB, voffB); PG8_STAGE(PG8_SA(0, 0), cA, voffA); PG8_STAGE(PG8_SB(0, 1), cB + hstep, voffB); PG8_STAGE(PG8_SA(0, 1), cA + hstep, voffA);
        if (wr == 1) PG8_BAR;
        PG8_WAIT_V(4); PG8_BAR;
        PG8_STAGE(PG8_SB(1, 0), cB + kstep, voffB); PG8_STAGE(PG8_SA(1, 0), cA + kstep, voffA); PG8_STAGE(PG8_SB(1, 1), cB + hstep + kstep, voffB);
        PG8_WAIT_V(6); PG8_BAR;
    }
    for (;;) {
        const bool has_next = S.next(ui + 1, nxt);
        const char* nA = has_next ? (const char*)g.A + (size_t)nxt.pm * tstep : cA; const char* nB = has_next ? (const char*)g.Bt + (size_t)nxt.pn * tstep : cB;
        for (int t = 0; t < nt; t += 2) {
            const bool last = (t == nt - 2);
            const char* a1 = cA + (size_t)(t + 1) * kstep;
            const char* a2 = last ? nA : cA + (size_t)(t + 2) * kstep; const char* b2 = last ? nB : cB + (size_t)(t + 2) * kstep;
            const char* a3 = a2 + kstep; const char* b3 = b2 + kstep;
            if (last && has_next) S.a_ready(nxt);
            if constexpr (SP2) {
            PG8_LDB(B0, 0, 0); PG8_LDB(B1, 0, 1); PG8_SCHED; PG8_LDA(At, 0, 0); PG8_STAGE(PG8_SA(1, 1), a1 + hstep, voffA);
            PG8_WAIT_V(8); PG8_WAIT_L(0); PG8_BAR; PG8_MMA(0, 0, At, B0); PG8_MMA(0, 1, At, B1); PG8_BAR; PG8_SCHED;
            PG8_LDA(At, 0, 1); PG8_STAGE(PG8_SB(0, 0), b2, voffB); PG8_STAGE(PG8_SB(0, 1), b2 + hstep, voffB); PG8_STAGE(PG8_SA(0, 0), a2, voffA);
            PG8_WAIT_V(8); PG8_WAIT_L(0); PG8_BAR; PG8_MMA(1, 0, At, B0); PG8_MMA(1, 1, At, B1); PG8_BAR; PG8_SCHED;
            PG8_LDB(B0, 1, 0); PG8_LDB(B1, 1, 1); PG8_SCHED; PG8_LDA(At, 1, 0); PG8_STAGE(PG8_SA(0, 1), a2 + hstep, voffA);
            PG8_WAIT_V(8); PG8_WAIT_L(0); PG8_BAR; PG8_MMA(0, 0, At, B0); PG8_MMA(0, 1, At, B1); PG8_BAR; PG8_SCHED;
            PG8_LDA(At, 1, 1); PG8_STAGE(PG8_SB(1, 0), b3, voffB); PG8_STAGE(PG8_SB(1, 1), b3 + hstep, voffB); PG8_STAGE(PG8_SA(1, 0), a3, voffA);
            PG8_WAIT_V(8); PG8_WAIT_L(0); PG8_BAR; PG8_MMA(1, 0, At, B0); PG8_MMA(1, 1, At, B1); PG8_BAR; PG8_SCHED;
            } else {
            PG8_LDB(B0, 0, 0); PG8_SCHED; PG8_LDA(At, 0, 0); PG8_STAGE(PG8_SA(1, 1), a1 + hstep, voffA);
            PG8_WAIT_L(8); PG8_BAR; PG8_WAIT_L(0); PG8_MMA(0, 0, At, B0); PG8_BAR; PG8_SCHED;
            PG8_LDB(B1, 0, 1); PG8_STAGE(PG8_SB(0, 0), b2, voffB);
            PG8_BAR; PG8_WAIT_L(0); PG8_MMA(0, 1, At, B1); PG8_BAR;
            PG8_LDA(At, 0, 1); PG8_STAGE(PG8_SA(0, 0), a2, voffA);
            PG8_BAR; PG8_WAIT_L(0); PG8_MMA(1, 0, At, B0); PG8_BAR; PG8_SCHED;
            PG8_STAGE(PG8_SB(0, 1), b2 + hstep, voffB);
            PG8_WAIT_V(6); PG8_BAR; PG8_MMA(1, 1, At, B1); PG8_BAR;
            PG8_LDB(B0, 1, 0); PG8_SCHED; PG8_LDA(At, 1, 0); PG8_STAGE(PG8_SA(0, 1), a2 + hstep, voffA);
            PG8_WAIT_L(8); PG8_BAR; PG8_WAIT_L(0); PG8_MMA(0, 0, At, B0); PG8_BAR; PG8_SCHED;
            PG8_LDB(B1, 1, 1); PG8_STAGE(PG8_SB(1, 0), b3, voffB);
            PG8_BAR; PG8_WAIT_L(0); PG8_MMA(0, 1, At, B1); PG8_BAR;
            PG8_LDA(At, 1, 1); PG8_STAGE(PG8_SA(1, 0), a3, voffA);
            PG8_BAR; PG8_WAIT_L(0); PG8_MMA(1, 0, At, B0); PG8_BAR; PG8_SCHED;
            PG8_STAGE(PG8_SB(1, 1), b3 + hstep, voffB);
            PG8_WAIT_V(6); PG8_BAR; PG8_MMA(1, 1, At, B1); PG8_BAR;
            }
        }
        if constexpr (ALIGN_EPI) { if (wr == 0) PG8_BAR; }
        if constexpr (!Epi::AFTER_DRAIN) { E(acc, cur, wr, wc, fr, fq); S.done(cur); }
        if (!has_next) break;
#pragma unroll
        for (int a = 0; a < 2; ++a)
#pragma unroll
            for (int b = 0; b < 2; ++b)
#pragma unroll
                for (int m = 0; m < 4; ++m)
#pragma unroll
                    for (int n = 0; n < 2; ++n) acc[a][b][m][n] = (f32x4){0.f, 0.f, 0.f, 0.f};
        cur = nxt; cA = nA; cB = nB; ++ui;
        if constexpr (ALIGN_EPI) { if (wr == 1) PG8_BAR; }
    }
    PG8_WAIT_V(0);
    if constexpr (!ALIGN_EPI) { if (wr == 0) PG8_BAR; }
    PG8_BAR;
    if constexpr (Epi::AFTER_DRAIN) { E.fused(acc, cur, wr, wc, fr, fq, lds, wid, lane); S.done(cur); }
#undef PG8_SA
#undef PG8_SB
#undef PG8_STAGE
#undef PG8_LDA
#undef PG8_LDB
#undef PG8_MMA
#undef PG8_WAIT_V
#undef PG8_WAIT_L
#undef PG8_BAR
#undef PG8_SCHED
}
}
#define DI __device__ __forceinline__
#define LAS __attribute__((address_space(3)))
typedef unsigned short bf16;
typedef unsigned v4u __attribute__((ext_vector_type(4)));
typedef unsigned v2u __attribute__((ext_vector_type(2)));
typedef float f32x4 __attribute__((ext_vector_type(4)));

constexpr int NB = 4, LSEQ = 8192, DM = 1024, LCTX = 256, NLAT = NB * LSEQ, NCTX = NB * LCTX, MTOT = NLAT + NCTX;
constexpr int INW = 3072, DFF = 2816, DFFH = 1408;
constexpr int CA_Q = 0, CA_K = 512, CA_V = 640, CB_QF = 768, CB_FF = 1024, CB_QB = 1280, CB_FB = 1536, CB_I = 1792, CB_G = 2048, CC_Q = 2304, CC_K = 2560, CC_V = 2816;
constexpr float EPS = 1e-6f;
constexpr size_t MiB = 1u << 20;
constexpr size_t WS_SMALL = 1 * MiB, WS_WIN = 2 * MiB, WS_WOUT = 14 * MiB, WS_WUP = 18 * MiB, WS_WDN = 40 * MiB, WS_XC = 52 * MiB, WS_H = 56 * MiB, WS_MIX = 122 * MiB,
                 WS_P = 188 * MiB, WS_ST = 386 * MiB, WS_U = 188 * MiB, WS_ACT = 370 * MiB, WS_END = 462 * MiB;
constexpr int SM_MOD = 0  , SM_TAC = 65536, SM_TAS = SM_TAC + 2048, SM_TDC = SM_TAS + 2048, SM_TDS = SM_TDC + 1024, SM_LOWER = SM_TDS + 1024  , SM_LAM = SM_LOWER + 1024;
constexpr int LDS_BYTES = 147456;

DI unsigned f2bf(float f) { unsigned u = __builtin_bit_cast(unsigned, f); return (u + 0x7fffu + ((u >> 16) & 1u)) >> 16; }
DI unsigned pk2(float lo, float hi) { return f2bf(lo) | (f2bf(hi) << 16); }
DI float bf2f(bf16 u) { return __builtin_bit_cast(float, ((unsigned)u) << 16); }
DI float shx_(int lane, float v, int m) { return __builtin_bit_cast(float, __builtin_amdgcn_ds_bpermute((lane ^ m) << 2, __builtin_bit_cast(int, v))); }
DI float wave_sum(int lane, float v) {
#pragma unroll
    for (int o = 1; o < 64; o <<= 1) v += shx_(lane, v, o);
    return v;
}
DI float wave_max(int lane, float v) {
#pragma unroll
    for (int o = 1; o < 64; o <<= 1) v = fmaxf(v, shx_(lane, v, o));
    return v;
}
DI float silu_f(float x) { return x / (1.f + __expf(-x)); }
DI float sigmoid_f(float x) { return 1.f / (1.f + __expf(-x)); }

struct Args { const float* in[23]; float* out; unsigned char* ws; };
struct Ctx {
    const float *x, *c, *ctx, *c_ctx, *w_mod, *b_mod, *n1g, *n2g, *w_in, *wqg, *wkg, *wsink, *hglow, *hgog, *dqg, *dkg, *dlam, *dog, *w_out, *w_up, *conv_w, *conv_b, *w_down;
    float* out; unsigned char* ws;
    float* SM; bf16 *Win_t, *Wout_t, *Wup_t, *Wdn_t, *H, *MIX, *P, *U, *ACT; float *XC, *ST;
    int lane, wave, tid, gw, NGW;
};


DI int fresh_lane() { int l_; asm volatile("v_mbcnt_lo_u32_b32 %0, -1, 0\n\tv_mbcnt_hi_u32_b32 %0, -1, %0" : "=v"(l_)); return l_; }
DI Ctx make_ctx(const Args& args, int wave_s) {
    Ctx C;
    C.x = args.in[0]; C.c = args.in[1]; C.ctx = args.in[2]; C.c_ctx = args.in[3]; C.w_mod = args.in[4]; C.b_mod = args.in[5]; C.n1g = args.in[6]; C.n2g = args.in[7];
    C.w_in = args.in[8]; C.wqg = args.in[9]; C.wkg = args.in[10]; C.wsink = args.in[11]; C.hglow = args.in[12]; C.hgog = args.in[13]; C.dqg = args.in[14]; C.dkg = args.in[15];
    C.dlam = args.in[16]; C.dog = args.in[17]; C.w_out = args.in[18]; C.w_up = args.in[19]; C.conv_w = args.in[20]; C.conv_b = args.in[21]; C.w_down = args.in[22];
    C.out = args.out; C.ws = args.ws;
    C.SM = (float*)(args.ws + WS_SMALL); C.Win_t = (bf16*)(args.ws + WS_WIN); C.Wout_t = (bf16*)(args.ws + WS_WOUT); C.Wup_t = (bf16*)(args.ws + WS_WUP); C.Wdn_t = (bf16*)(args.ws + WS_WDN);
    C.XC = (float*)(args.ws + WS_XC); C.H = (bf16*)(args.ws + WS_H); C.MIX = (bf16*)(args.ws + WS_MIX); C.P = (bf16*)(args.ws + WS_P); C.ST = (float*)(args.ws + WS_ST);
    C.U = (bf16*)(args.ws + WS_U); C.ACT = (bf16*)(args.ws + WS_ACT);
    C.lane = fresh_lane(); C.wave = wave_s; C.tid = wave_s * 64 + C.lane; C.gw = blockIdx.x * 8 + C.wave; C.NGW = gridDim.x * 8;
    return C;
}

DI void p0_transpose_item(const float* W, int N, int k0, int n0, bf16* dst, int dst_ld, LAS float* scr, int lane) {
    f32x4 v[8];
#pragma unroll
    for (int i = 0; i < 8; ++i) v[i] = __builtin_nontemporal_load((const f32x4*)(W + (size_t)(k0 + 8 * i + (lane >> 3)) * N + n0 + 4 * (lane & 7)));
#pragma unroll
    for (int i = 0; i < 8; ++i) { LAS float* q = scr + (8 * i + (lane >> 3)) * 33 + 4 * (lane & 7); q[0] = v[i].x; q[1] = v[i].y; q[2] = v[i].z; q[3] = v[i].w; }
    asm volatile("s_waitcnt lgkmcnt(0)" ::: "memory");
    const int c = lane & 7;
#pragma unroll
    for (int j = 0; j < 4; ++j) { const int n = (lane >> 3) + 8 * j; const LAS float* s = scr + (8 * c) * 33 + n;
        v4u o; o.x = pk2(s[0 * 33], s[1 * 33]); o.y = pk2(s[2 * 33], s[3 * 33]); o.z = pk2(s[4 * 33], s[5 * 33]); o.w = pk2(s[6 * 33], s[7 * 33]);
        __builtin_nontemporal_store(o, (v4u*)(dst + (size_t)n * dst_ld + 8 * c)); }
    asm volatile("s_waitcnt lgkmcnt(0)" ::: "memory");
}
DI int permup(int n) { const int a = n >= DFF ? 1 : 0; const int ch = n - a * DFF; return (ch >> 7) * 256 + a * 128 + (ch & 127); }

DI void p0_phase(const Args& A, int wave_s, LAS unsigned char* lds) {
    const Ctx C = make_ctx(A, wave_s);
    {
        LAS float* sv = (LAS float*)lds;
        LAS float* red = (LAS float*)(lds + 32768);
        for (int unit = blockIdx.x; unit < 192; unit += gridDim.x) {
            const int l = unit / 96, c0 = (unit % 96) * 64;
            __syncthreads();
            for (int e = C.tid; e < 5120; e += 512) { const int v = e >> 10, k = e & 1023; const float xv = v < 4 ? C.c[v * 1024 + k] : C.c_ctx[k]; sv[e] = silu_f(xv); }
            __syncthreads();
            const float* W = C.w_mod + (size_t)l * 1024 * 6144 + c0 + C.lane;
            float a0 = 0.f, a1 = 0.f, a2 = 0.f, a3 = 0.f, a4 = 0.f;
            const int kb = C.wave * 128;
#pragma unroll 16
            for (int k = 0; k < 128; ++k) { const float w = __builtin_nontemporal_load(W + (size_t)(kb + k) * 6144);
                a0 += sv[kb + k] * w; a1 += sv[1024 + kb + k] * w; a2 += sv[2048 + kb + k] * w; a3 += sv[3072 + kb + k] * w; a4 += sv[4096 + kb + k] * w; }
            red[(C.wave * 5 + 0) * 64 + C.lane] = a0; red[(C.wave * 5 + 1) * 64 + C.lane] = a1; red[(C.wave * 5 + 2) * 64 + C.lane] = a2;
            red[(C.wave * 5 + 3) * 64 + C.lane] = a3; red[(C.wave * 5 + 4) * 64 + C.lane] = a4;
            __syncthreads();
            if (C.tid < 320) { const int v = C.tid >> 6, cc = C.tid & 63; float s = 0.f;
#pragma unroll
                for (int w = 0; w < 8; ++w) s += red[(w * 5 + v) * 64 + cc];
                C.SM[SM_MOD + (l * 5 + v) * 6144 + c0 + cc] = s + C.b_mod[l * 6144 + c0 + cc]; }
        }
        __syncthreads();
    }
    if (blockIdx.x == gridDim.x - 1) {
        for (int e = C.tid; e < 2048; e += 512) { const int p = e >> 4, i = e & 15;
            const float inv = exp2f((float)(-(double)i / 16.0 * 13.287712379549449)); const float ang = (float)p * inv;
            const double ad = (double)ang * 0.15915494309189535; const double kk = __builtin_rint(ad); const float rev = (float)(ad - kk);
            C.SM[SM_TAC + e] = __builtin_amdgcn_cosf(rev); C.SM[SM_TAS + e] = __builtin_amdgcn_sinf(rev); }
        for (int e = C.tid; e < 1024; e += 512) { const int p = e >> 3, i = e & 7;
            const float inv = exp2f((float)(-(double)i / 8.0 * 13.287712379549449)); const float ang = (float)p * inv;
            const double ad = (double)ang * 0.15915494309189535; const double kk = __builtin_rint(ad); const float rev = (float)(ad - kk);
            C.SM[SM_TDC + e] = __builtin_amdgcn_cosf(rev); C.SM[SM_TDS + e] = __builtin_amdgcn_sinf(rev); }
        for (int e = C.tid; e < 512; e += 512) { C.SM[SM_LOWER + e] = 0.f; C.SM[SM_LOWER + 512 + e] = 1.f / (1.f + __expf(C.hglow[e] - C.hglow[512 + e])); }
        if (C.wave == 0) {
            for (int l = 0; l < 2; ++l) { const float* L = C.dlam + l * 128;
                float a = C.lane < 32 ? L[C.lane] * L[32 + C.lane] : 0.f, b = C.lane < 32 ? L[64 + C.lane] * L[96 + C.lane] : 0.f;
                a = wave_sum(C.lane, a); b = wave_sum(C.lane, b);
                const float lam_init = 0.8f - 0.6f * __expf(-0.3f * (float)l);
                if (C.lane == 0) C.SM[SM_LAM + l] = __expf(a) - __expf(b) + lam_init; }
        }
    }
}
DI void p0_transposes(const Args& A, int wave_s, LAS unsigned char* lds, int it_lo, int it_hi, int widx, int nworkers) {
    const Ctx C = make_ctx(A, wave_s);
    LAS float* scr = (LAS float*)(lds + 49152 + C.wave * 8704);
    constexpr int I_IN = 16 * 96, I_OUT = 16 * 32, I_UP = 16 * 176, I_DN = 44 * 32, I_L = I_IN + I_OUT + I_UP + I_DN;
    for (int it = it_lo + widx; it < it_hi; it += nworkers) {
        const int l = it / I_L; int r = it % I_L;
        if (r < I_IN) { const int kb = r / 96, nb = r % 96; p0_transpose_item(C.w_in + (size_t)l * 1024 * 3072, 3072, 64 * kb, 32 * nb, C.Win_t + (size_t)l * 3072 * 1024 + (size_t)(32 * nb) * 1024 + 64 * kb, 1024, scr, C.lane); continue; } r -= I_IN;
        if (r < I_OUT) { const int kb = r / 32, nb = r % 32; p0_transpose_item(C.w_out + (size_t)l * 1024 * 1024, 1024, 64 * kb, 32 * nb, C.Wout_t + (size_t)l * 1024 * 1024 + (size_t)(32 * nb) * 1024 + 64 * kb, 1024, scr, C.lane); continue; } r -= I_OUT;
        if (r < I_UP) { const int kb = r / 176, nb = r % 176; p0_transpose_item(C.w_up + (size_t)l * 1024 * 5632, 5632, 64 * kb, 32 * nb, C.Wup_t + (size_t)l * 5632 * 1024 + (size_t)permup(32 * nb) * 1024 + 64 * kb, 1024, scr, C.lane); continue; } r -= I_UP;
        { const int kb = r / 32, nb = r % 32; const int k0 = 64 * kb;
          p0_transpose_item(C.w_down + (size_t)l * 2816 * 1024, 1024, k0, 32 * nb, C.Wdn_t + (size_t)l * 2816 * 1024 + (size_t)(32 * nb) * DFF + k0, DFF, scr, C.lane); }
    }
}

DI void norm_phase(const Args& A, int wave_s, int l, int which, int rows) {
    const Ctx C = make_ctx(A, wave_s);
    const float* gn = (which == 1 ? C.n1g : C.n2g) + l * 1024;
    const bool from_in = (l == 0 && which == 1);
    f32x4 g[4];
#pragma unroll
    for (int j = 0; j < 4; ++j) g[j] = *(const f32x4*)(gn + 4 * (C.lane + 64 * j));
    for (int m0 = C.gw * 2; m0 < rows; m0 += C.NGW * 2) {
        f32x4 xv[2][4];
        const float* modp[2];
#pragma unroll
        for (int rr = 0; rr < 2; ++rr) {
            const int m = m0 + rr; const float* xr; int v;
            if (m < NLAT) { xr = (from_in ? C.x : C.out) + (size_t)m * 1024; v = m >> 13; }
            else { xr = (from_in ? C.ctx : C.XC) + (size_t)(m - NLAT) * 1024; v = 4; }
            modp[rr] = C.SM + SM_MOD + (l * 5 + v) * 6144 + (which == 1 ? 0 : 3072);
#pragma unroll
            for (int j = 0; j < 4; ++j) xv[rr][j] = ((const f32x4*)xr)[C.lane + 64 * j];
        }
#pragma unroll
        for (int rr = 0; rr < 2; ++rr) {
            const int m = m0 + rr;
            f32x4 sh[4], sc[4];
#pragma unroll
            for (int j = 0; j < 4; ++j) { const int col = 4 * (C.lane + 64 * j); sh[j] = *(const f32x4*)(modp[rr] + col); sc[j] = *(const f32x4*)(modp[rr] + 1024 + col); }
            float ss = 0.f;
#pragma unroll
            for (int j = 0; j < 4; ++j) ss += (xv[rr][j].x * xv[rr][j].x + xv[rr][j].y * xv[rr][j].y) + (xv[rr][j].z * xv[rr][j].z + xv[rr][j].w * xv[rr][j].w);
            ss = wave_sum(C.lane, ss);
            const float rs = rsqrtf(ss * (1.f / 1024.f) + EPS);
#pragma unroll
            for (int j = 0; j < 4; ++j) { const int col = 4 * (C.lane + 64 * j);
                const f32x4 y = xv[rr][j] * rs * g[j] * (sc[j] + 1.f) + sh[j];
                v2u o; o.x = pk2(y.x, y.y); o.y = pk2(y.z, y.w);
                *(v2u*)(C.H + (size_t)m * 1024 + col) = o; }
        }
    }
}

DI void unpack8(const v4u w, float (&x)[8]) {
#pragma unroll
    for (int q = 0; q < 4; ++q) { x[2 * q] = __builtin_bit_cast(float, w[q] << 16); x[2 * q + 1] = __builtin_bit_cast(float, w[q] & 0xffff0000u); }
}
DI void prep_phase(const Args& A, int wave_s, int l) {
    const Ctx C = make_ctx(A, wave_s);
    const int L = C.lane, jA = L & 7, jD = L & 3;
    float gqA[8], gkA[8], gD[8];
#pragma unroll
    for (int e = 0; e < 8; ++e) { gqA[e] = C.wqg[l * 64 + 8 * jA + e] * (0.125f * 1.4426950408889634f); gkA[e] = C.wkg[l * 64 + 8 * jA + e];
        gD[e] = (L < 32) ? C.dqg[l * 32 + 8 * jD + e] * (0.17677669529663687f * 1.4426950408889634f) : C.dkg[l * 32 + 8 * jD + e]; }
    const float* TAC = C.SM + SM_TAC; const float* TAS = C.SM + SM_TAS; const float* TDC = C.SM + SM_TDC; const float* TDS = C.SM + SM_TDS;
    for (int m = C.gw; m < MTOT; m += C.NGW) {
        bf16* pr = C.P + (size_t)m * INW;
        const bool latent = m < NLAT; const int t = m & 8191, rpos = t >> 6, cpos = t & 63;
        const v4u wq = *(const v4u*)(pr + 8 * L), wk = (L < 16) ? *(const v4u*)(pr + 512 + 8 * L) : (v4u){0u, 0u, 0u, 0u}, wd = *(const v4u*)(pr + CC_Q + 8 * L);
        float cA[8], sA[8], cD[8], sD[8];
        if (latent) { const int posA = (jA < 4) ? rpos : cpos, iA = 8 * (jA & 1); const int posD = (jD < 2) ? rpos : cpos;
#pragma unroll
            for (int e = 0; e < 8; ++e) { cA[e] = TAC[posA * 16 + iA + e]; sA[e] = TAS[posA * 16 + iA + e]; cD[e] = TDC[posD * 8 + e]; sD[e] = TDS[posD * 8 + e]; }
        } else {
#pragma unroll
            for (int e = 0; e < 8; ++e) { cA[e] = 1.f; sA[e] = 0.f; cD[e] = 1.f; sD[e] = 0.f; }
        }
#pragma unroll
        for (int part = 0; part < 2; ++part) {
            float x[8]; unpack8(part ? wk : wq, x);
            float ss = 0.f;
#pragma unroll
            for (int e = 0; e < 8; ++e) ss += x[e] * x[e];
            ss += shx_(L, ss, 1); ss += shx_(L, ss, 2); ss += shx_(L, ss, 4);
            const float rs = rsqrtf(ss * (1.f / 64.f) + EPS);
            float y[8], y2[8];
#pragma unroll
            for (int e = 0; e < 8; ++e) y[e] = x[e] * rs * (part ? gkA[e] : gqA[e]);
#pragma unroll
            for (int e = 0; e < 8; ++e) y2[e] = shx_(L, y[e], 2);
            unsigned o[4];
#pragma unroll
            for (int q = 0; q < 4; ++q) { float r0, r1;
                { const int e = 2 * q; r0 = (jA & 2) ? (y2[e] * sA[e] + y[e] * cA[e]) : (y[e] * cA[e] - y2[e] * sA[e]); }
                { const int e = 2 * q + 1; r1 = (jA & 2) ? (y2[e] * sA[e] + y[e] * cA[e]) : (y[e] * cA[e] - y2[e] * sA[e]); }
                o[q] = pk2(r0, r1); }
            const v4u ov = {o[0], o[1], o[2], o[3]};
            if (part == 0) *(v4u*)(pr + 8 * L) = ov; else if (L < 16) *(v4u*)(pr + 512 + 8 * L) = ov;
        }
        {
            float x[8]; unpack8(wd, x);
            float ss = 0.f;
#pragma unroll
            for (int e = 0; e < 8; ++e) ss += x[e] * x[e];
            ss += shx_(L, ss, 1); ss += shx_(L, ss, 2);
            const float rs = rsqrtf(ss * (1.f / 32.f) + EPS);
            float y[8], y2[8];
#pragma unroll
            for (int e = 0; e < 8; ++e) y[e] = x[e] * rs * gD[e];
#pragma unroll
            for (int e = 0; e < 8; ++e) y2[e] = shx_(L, y[e], 1);
            unsigned o[4];
#pragma unroll
            for (int q = 0; q < 4; ++q) { float r0, r1;
                { const int e = 2 * q; r0 = (jD & 1) ? (y2[e] * sD[e] + y[e] * cD[e]) : (y[e] * cD[e] - y2[e] * sD[e]); }
                { const int e = 2 * q + 1; r1 = (jD & 1) ? (y2[e] * sD[e] + y[e] * cD[e]) : (y[e] * cD[e] - y2[e] * sD[e]); }
                o[q] = pk2(r0, r1); }
            *(v4u*)(pr + CC_Q + 8 * L) = (v4u){o[0], o[1], o[2], o[3]};
        }
    }
}

DI void hgrn_naive(const Args& A, int wave_s, int l, bool need_ctx) {
    const Ctx C = make_ctx(A, wave_s);
    const float og = C.hgog[l * 64 + C.lane];
    for (int task = C.gw; task < 16; task += C.NGW) {
        const int b = task >> 2, h = task & 3;
        for (int dir = 0; dir < 2; ++dir) {
            const float lbv = C.SM[SM_LOWER + (l * 2 + dir) * 256 + h * 64 + C.lane];
            float S[64];
#pragma unroll
            for (int k = 0; k < 64; ++k) S[k] = 0.f;
            const int qcol = (dir ? CB_QB : CB_QF) + h * 64 + C.lane, fcol = (dir ? CB_FB : CB_FF) + h * 64 + C.lane;
            for (int step = 0; step < LCTX + LSEQ; ++step) {
                int r;
                if (step < LCTX) { const int tc = dir ? (LCTX - 1 - step) : step; r = NLAT + b * LCTX + tc; }
                else { const int t0 = step - LCTX; const int t = dir ? (LSEQ - 1 - t0) : t0; r = b * LSEQ + t; }
                const bf16* pr = C.P + (size_t)r * INW;
                const float qv = bf2f(pr[qcol]), pf = bf2f(pr[fcol]), iv = bf2f(pr[CB_I + h * 64 + C.lane]);
                const float f = lbv + (1.f - lbv) * sigmoid_f(pf), kk = 1.f - f;
                float o = 0.f;
#pragma unroll
                for (int k = 0; k < 64; ++k) {
                    const float fk = __builtin_bit_cast(float, __builtin_amdgcn_readlane(__builtin_bit_cast(int, f), k));
                    const float kx = __builtin_bit_cast(float, __builtin_amdgcn_readlane(__builtin_bit_cast(int, kk), k));
                    const float qk = __builtin_bit_cast(float, __builtin_amdgcn_readlane(__builtin_bit_cast(int, qv), k));
                    S[k] = fk * S[k] + kx * iv; o += S[k] * qk;
                }
                float* op = C.ST + (size_t)r * 256 + h * 64 + C.lane;
                if (dir == 0) { *op = o; }
                else if (r < NLAT || need_ctx) {
                    const float tot = *op + o; const float ss = wave_sum(C.lane, tot * tot);
                    const float g = bf2f(pr[CB_G + h * 64 + C.lane]);
                    const float y = tot * rsqrtf(ss * (1.f / 64.f) + EPS) * og * silu_f(g);
                    C.MIX[(size_t)r * 1024 + 512 + h * 64 + C.lane] = (bf16)f2bf(y);
                }
            }
        }
    }
}

DI void win_naive(const Args& A, int wave_s, int l, bool need_ctx) {
    const Ctx C = make_ctx(A, wave_s);
    const float Mb = 8.f * 1.4426950408889634f * wave_max(C.lane, fabsf(C.wqg[l * 64 + C.lane])) * wave_max(C.lane, fabsf(C.wkg[l * 64 + C.lane]));
    const int ntask = (need_ctx ? MTOT : NLAT) * 8;
    for (int task = C.gw; task < ntask; task += C.NGW) {
        const int m = task >> 3, h = task & 7, kv = h >> 2;
        const float qx = bf2f(C.P[(size_t)m * INW + CA_Q + h * 64 + C.lane]);
        float lsum = 0.f, acc = 0.f;
        int b;
        if (m < NLAT) {
            b = m >> 13; const int t = m & 8191; const int lo = t - 128 < 0 ? 0 : t - 128, hi = t + 128 > LSEQ - 1 ? LSEQ - 1 : t + 128;
            for (int kt = lo; kt <= hi; ++kt) { const bf16* kr = C.P + (size_t)(b * LSEQ + kt) * INW;
                const float s = wave_sum(C.lane, qx * bf2f(kr[CA_K + kv * 64 + C.lane])); const float e = __builtin_amdgcn_exp2f(s - Mb);
                lsum += e; acc += e * bf2f(kr[CA_V + kv * 64 + C.lane]); }
        } else b = (m - NLAT) >> 8;
        for (int kc = 0; kc < LCTX; ++kc) { const bf16* kr = C.P + (size_t)(NLAT + b * LCTX + kc) * INW;
            const float s = wave_sum(C.lane, qx * bf2f(kr[CA_K + kv * 64 + C.lane])); const float e = __builtin_amdgcn_exp2f(s - Mb);
            lsum += e; acc += e * bf2f(kr[CA_V + kv * 64 + C.lane]); }
        const float o = acc / (lsum + __builtin_amdgcn_exp2f(C.wsink[l * 8 + h] * 1.4426950408889634f - Mb));
        C.MIX[(size_t)m * 1024 + h * 64 + C.lane] = (bf16)f2bf(o);
    }
}

DI void diff_naive(const Args& A, int wave_s, int l, bool need_ctx) {
    const Ctx C = make_ctx(A, wave_s);
    const float Mb = 5.656854249f * wave_max(C.lane, fabsf(C.dqg[l * 32 + (C.lane & 31)])) * wave_max(C.lane, fabsf(C.dkg[l * 32 + (C.lane & 31)]));
    const float lam = C.SM[SM_LAM + l]; const float lam_init = 0.8f - 0.6f * __expf(-0.3f * (float)l);
    const float og = C.dog[l * 64 + C.lane];
    const int ntask = (need_ctx ? MTOT : NLAT) * 4;
    for (int task = C.gw; task < ntask; task += C.NGW) {
        const int m = task >> 2, h = task & 3;
        const float qx = bf2f(C.P[(size_t)m * INW + CC_Q + h * 64 + C.lane]);
        float l0 = 0.f, l1 = 0.f, a0 = 0.f, a1 = 0.f;
        const bool latent = m < NLAT; const int b = latent ? (m >> 13) : ((m - NLAT) >> 8);
        const int nk = latent ? LSEQ + LCTX : LCTX;
        for (int j = 0; j < nk; ++j) {
            const int r = latent ? (j < LSEQ ? b * LSEQ + j : NLAT + b * LCTX + (j - LSEQ)) : NLAT + b * LCTX + j;
            const bf16* kr = C.P + (size_t)r * INW;
            float pr = qx * bf2f(kr[CC_K + h * 64 + C.lane]);
#pragma unroll
            for (int o = 1; o < 32; o <<= 1) pr += shx_(C.lane, pr, o);
            const float po = shx_(C.lane, pr, 32);
            const float s0 = (C.lane < 32 ? pr : po) * 0.17677669529663687f, s1 = (C.lane < 32 ? po : pr) * 0.17677669529663687f;
            const float e0 = __expf(s0 - Mb), e1 = __expf(s1 - Mb);
            const float vv = bf2f(kr[CC_V + h * 64 + C.lane]);
            l0 += e0; l1 += e1; a0 += e0 * vv; a1 += e1 * vv;
        }
        const float o = a0 / l0 - lam * (a1 / l1);
        const float ss = wave_sum(C.lane, o * o);
        const float y = o * rsqrtf(ss * (1.f / 64.f) + EPS) * og * (1.f - lam_init);
        C.MIX[(size_t)m * 1024 + 768 + h * 64 + C.lane] = (bf16)f2bf(y);
    }
}


typedef short bf16x8 __attribute__((ext_vector_type(8)));
typedef short s16x4 __attribute__((ext_vector_type(4)));
typedef float f32x16 __attribute__((ext_vector_type(16)));
typedef __bf16 bfv2 __attribute__((ext_vector_type(2)));
typedef float fv2 __attribute__((ext_vector_type(2)));
DI unsigned pkbf(float a, float b) { fv2 v = {a, b}; return __builtin_bit_cast(unsigned, __builtin_convertvector(v, bfv2)); }
#define MFMA32(a, b, c) __builtin_amdgcn_mfma_f32_32x32x16_bf16((a), (b), (c), 0, 0, 0)
#define PACK8(x, s) __builtin_bit_cast(bf16x8, (v4u){pkbf((x)[8 * (s)], (x)[8 * (s) + 1]), pkbf((x)[8 * (s) + 2], (x)[8 * (s) + 3]), pkbf((x)[8 * (s) + 4], (x)[8 * (s) + 5]), pkbf((x)[8 * (s) + 6], (x)[8 * (s) + 7])})
DI bf16x8 tr_pair(LAS unsigned char* p) {
    const s16x4 lo = __builtin_amdgcn_ds_read_tr16_b64_v4i16((LAS s16x4*)p), hi = __builtin_amdgcn_ds_read_tr16_b64_v4i16((LAS s16x4*)(p + 8 * 144));
    return __builtin_shufflevector(lo, hi, 0, 1, 2, 3, 4, 5, 6, 7);
}
constexpr int KV_PITCH = 144, KV_IMG = 64 * KV_PITCH;
constexpr int VP = 192;
DI bf16x8 tr_pairV(LAS unsigned char* p) {
    const s16x4 lo = __builtin_amdgcn_ds_read_tr16_b64_v4i16((LAS s16x4*)p), hi = __builtin_amdgcn_ds_read_tr16_b64_v4i16((LAS s16x4*)(p + 8 * VP));
    return __builtin_shufflevector(lo, hi, 0, 1, 2, 3, 4, 5, 6, 7);
}

constexpr int DT_ROWS = 128, DT_IMG = DT_ROWS * KV_PITCH;
DI void diff_mfma_phase(const Args& A, int wave_s, int l, bool need_ctx, LAS unsigned char* lds) {
    const Ctx C = make_ctx(A, wave_s);
    const int lane = C.lane, wave = C.wave, r = lane & 31, h = lane >> 5;
    const float Mb2 = 5.656854249f * 1.4426950408889634f * wave_max(C.lane, fabsf(C.dqg[l * 32 + (lane & 31)])) * wave_max(C.lane, fabsf(C.dkg[l * 32 + (lane & 31)]));
    const float lam = C.SM[SM_LAM + l]; const float lam_init = 0.8f - 0.6f * __expf(-0.3f * (float)l);
    const int nunits = 512 + (need_ctx ? 16 : 0);
    const int srow = C.tid >> 3, sch = C.tid & 7;
    const unsigned sgoff = (unsigned)(srow * INW + sch * 8) * 2u;
    const int q4 = (lane & 15) >> 2, p4 = lane & 3, grp = (lane >> 4) & 1;
    const int voff = (4 * h + q4) * VP + (16 * grp + 4 * p4) * 2;
    constexpr int DV_IMG = DT_ROWS * VP, VOFF0 = 2 * DT_IMG;
    f32x16 negM;
#pragma unroll
    for (int i = 0; i < 16; ++i) negM[i] = 0.f;
    (void)Mb2;
    for (int u = blockIdx.x; u < nunits; u += gridDim.x) {
        int b, hd, qrow0, ntiles;
        if (u < 512) { b = u >> 7; hd = (u >> 5) & 3; qrow0 = b * LSEQ + (u & 31) * 256; ntiles = 66; }
        else { const int uu = u - 512; b = uu >> 2; hd = uu & 3; qrow0 = NLAT + b * LCTX; ntiles = 2; }
        const int kbase0 = (u < 512) ? b * LSEQ : NLAT + b * LCTX, kbase1 = NLAT + b * LCTX - 64 * DT_ROWS;
        const bf16* qp = C.P + (size_t)qrow0 * INW + CC_Q + hd * 64 + (unsigned)((wave * 32 + r) * INW);
        bf16x8 Qf[2][2];
#pragma unroll
        for (int c = 0; c < 2; ++c)
#pragma unroll
            for (int s = 0; s < 2; ++s) Qf[c][s] = *(const bf16x8*)(qp + c * 32 + s * 16 + h * 8);
        f32x16 O[2][2];
#pragma unroll
        for (int c = 0; c < 2; ++c)
#pragma unroll
            for (int mt = 0; mt < 2; ++mt)
#pragma unroll
                for (int i = 0; i < 16; ++i) O[c][mt][i] = 0.f;
        float ls0 = 0.f, ls1 = 0.f;
        bf16x8 Pp0 = {0, 0, 0, 0, 0, 0, 0, 0}, Pp1 = {0, 0, 0, 0, 0, 0, 0, 0};
        bf16x8 Vs[4];
#pragma unroll
        for (int b_ = 0; b_ < 4; ++b_) Vs[b_] = (bf16x8){0, 0, 0, 0, 0, 0, 0, 0};
        v4u kreg[2], vreg[2];
        { const char* kb_ = (const char*)(C.P + (size_t)kbase0 * INW + CC_K + hd * 64); const char* vb_ = (const char*)(C.P + (size_t)kbase0 * INW + CC_V + hd * 64);
          kreg[0] = *(const v4u*)(kb_ + sgoff); vreg[0] = *(const v4u*)(vb_ + sgoff);
          kreg[1] = *(const v4u*)(kb_ + (size_t)64 * INW * 2 + sgoff); vreg[1] = *(const v4u*)(vb_ + (size_t)64 * INW * 2 + sgoff); }
        __syncthreads();
        *(LAS v4u*)(lds + srow * KV_PITCH + sch * 16) = kreg[0]; *(LAS v4u*)(lds + (srow + 64) * KV_PITCH + sch * 16) = kreg[1];
        *(LAS v4u*)(lds + VOFF0 + srow * VP + sch * 16) = vreg[0]; *(LAS v4u*)(lds + VOFF0 + (srow + 64) * VP + sch * 16) = vreg[1];
        __syncthreads();
        for (int it = 0; it < ntiles; ++it) {
            const int cur = it & 1;
            if (it + 1 < ntiles) { const int kr0 = (it + 1 < 64 ? kbase0 : kbase1) + (it + 1) * DT_ROWS;
                const char* kb_ = (const char*)(C.P + (size_t)kr0 * INW + CC_K + hd * 64);
                kreg[0] = *(const v4u*)(kb_ + sgoff); kreg[1] = *(const v4u*)(kb_ + (size_t)64 * INW * 2 + sgoff); }
            LAS unsigned char* Kb = lds + cur * DT_IMG; LAS unsigned char* Vb = lds + VOFF0 + cur * DV_IMG;
            LAS unsigned char* kl = Kb + r * KV_PITCH + h * 16;
            f32x16 Sc;
            { const bf16x8 kA0 = *(LAS bf16x8*)(kl), kA1 = *(LAS bf16x8*)(kl + 32); Sc = MFMA32(kA0, Qf[0][0], negM); Sc = MFMA32(kA1, Qf[0][1], Sc); }
#pragma unroll
            for (int g = 0; g < 8; ++g) {
                const int c = g & 1, sub = g >> 1;
                bf16x8 kB0, kB1; f32x16 Sn;
                if (g < 7) { LAS unsigned char* kp = kl + (32 * ((g + 1) >> 1)) * KV_PITCH + (c ^ 1) * 64; kB0 = *(LAS bf16x8*)(kp); kB1 = *(LAS bf16x8*)(kp + 32); }
                if (c == 0) { O[1][0] = MFMA32(Vs[0], Pp0, O[1][0]); O[1][1] = MFMA32(Vs[2], Pp0, O[1][1]); O[1][0] = MFMA32(Vs[1], Pp1, O[1][0]); O[1][1] = MFMA32(Vs[3], Pp1, O[1][1]); }
                else        { O[0][0] = MFMA32(Vs[0], Pp0, O[0][0]); O[0][1] = MFMA32(Vs[2], Pp0, O[0][1]); O[0][0] = MFMA32(Vs[1], Pp1, O[0][0]); O[0][1] = MFMA32(Vs[3], Pp1, O[0][1]); }
                float t = 0.f;
#pragma unroll
                for (int i = 0; i < 8; ++i) { Sc[i] = __builtin_amdgcn_exp2f(Sc[i]); t += Sc[i]; }
                const bf16x8 Pn0 = PACK8(Sc, 0);
                __builtin_amdgcn_sched_barrier(0);
                if (g < 7) { Sn = MFMA32(kB0, Qf[c ^ 1][0], negM); Sn = MFMA32(kB1, Qf[c ^ 1][1], Sn); }
                __builtin_amdgcn_sched_barrier(0);
                if (c == 0) { LAS unsigned char* vp = Vb + (32 * sub) * VP + voff; Vs[0] = tr_pairV(vp); Vs[1] = tr_pairV(vp + 16 * VP); Vs[2] = tr_pairV(vp + 64); Vs[3] = tr_pairV(vp + 16 * VP + 64); }
#pragma unroll
                for (int i = 8; i < 16; ++i) { Sc[i] = __builtin_amdgcn_exp2f(Sc[i]); t += Sc[i]; }
                if (c == 0) ls0 += t; else ls1 += t;
                Pp0 = Pn0; Pp1 = PACK8(Sc, 1);
                if (g < 7) Sc = Sn;
                __builtin_amdgcn_sched_barrier(0);
                if (g == 3 && it + 1 < ntiles) {
                    LAS unsigned char* kb2 = lds + (cur ^ 1) * DT_IMG;
                    *(LAS v4u*)(kb2 + srow * KV_PITCH + sch * 16) = kreg[0]; *(LAS v4u*)(kb2 + (srow + 64) * KV_PITCH + sch * 16) = kreg[1];
                    const int kr0 = (it + 1 < 64 ? kbase0 : kbase1) + (it + 1) * DT_ROWS;
                    const char* vb_ = (const char*)(C.P + (size_t)kr0 * INW + CC_V + hd * 64);
                    kreg[0] = *(const v4u*)(vb_ + sgoff); kreg[1] = *(const v4u*)(vb_ + (size_t)64 * INW * 2 + sgoff);
                    __builtin_amdgcn_sched_barrier(0);
                }
            }
            if (it + 1 < ntiles) { LAS unsigned char* vb2 = lds + VOFF0 + (cur ^ 1) * DV_IMG;
                *(LAS v4u*)(vb2 + srow * VP + sch * 16) = kreg[0]; *(LAS v4u*)(vb2 + (srow + 64) * VP + sch * 16) = kreg[1]; }
            __syncthreads();
        }
        O[1][0] = MFMA32(Vs[0], Pp0, O[1][0]); O[1][1] = MFMA32(Vs[2], Pp0, O[1][1]); O[1][0] = MFMA32(Vs[1], Pp1, O[1][0]); O[1][1] = MFMA32(Vs[3], Pp1, O[1][1]);
        ls0 += shx_(C.lane, ls0, 32); ls1 += shx_(C.lane, ls1, 32);
        const float inv0 = 1.f / ls0, inv1 = lam / ls1;
        float ss = 0.f;
#pragma unroll
        for (int mt = 0; mt < 2; ++mt)
#pragma unroll
            for (int i = 0; i < 16; ++i) { const float o = O[0][mt][i] * inv0 - O[1][mt][i] * inv1; O[0][mt][i] = o; ss += o * o; }
        ss += shx_(C.lane, ss, 32);
        const float rs = rsqrtf(ss * (1.f / 64.f) + EPS) * (1.f - lam_init);
        bf16* op = C.MIX + (size_t)qrow0 * 1024 + 768 + hd * 64 + (unsigned)((wave * 32 + r) * 1024);
#pragma unroll
        for (int mt = 0; mt < 2; ++mt)
#pragma unroll
            for (int g = 0; g < 4; ++g) { const int dv0 = 32 * mt + 8 * g + 4 * h; const f32x4 og = *(const f32x4*)(C.dog + l * 64 + dv0);
                v2u w; w.x = pkbf(O[0][mt][4 * g] * rs * og.x, O[0][mt][4 * g + 1] * rs * og.y); w.y = pkbf(O[0][mt][4 * g + 2] * rs * og.z, O[0][mt][4 * g + 3] * rs * og.w);
                *(v2u*)(op + dv0) = w; }
    }
}

DI void win_mfma_phase(const Args& A, int wave_s, int l, bool need_ctx, LAS unsigned char* lds) {
    const Ctx C = make_ctx(A, wave_s);
    const int lane = C.lane, wave = C.wave, r = lane & 31, h = lane >> 5;
    const float Mb2 = 8.f * 1.4426950408889634f * wave_max(C.lane, fabsf(C.wqg[l * 64 + lane])) * wave_max(C.lane, fabsf(C.wkg[l * 64 + lane]));
    const int nunits = 1024 + (need_ctx ? 32 : 0);
    const int srow = C.tid >> 3, sch = C.tid & 7;
    const int q4 = (lane & 15) >> 2, p4 = lane & 3, grp = (lane >> 4) & 1;
    const int voff = (4 * h + q4) * KV_PITCH + (16 * grp + 4 * p4) * 2;
    const int g = wave >> 1, qh = wave & 1;
    for (int u = blockIdx.x; u < nunits; u += gridDim.x) {
        int b, kv, qrow0, t0, ntiles, tfirst;
        bool lat;
        if (u < 1024) { lat = true; b = u >> 8; kv = (u >> 7) & 1; t0 = (u & 127) * 64; qrow0 = b * LSEQ + t0; }
        else { lat = false; const int uu = u - 1024; b = uu >> 3; kv = (uu >> 2) & 1; t0 = (uu & 3) * 64; qrow0 = NLAT + b * LCTX + t0; }
        const int ilo = lat ? (t0 >= 128 ? 0 : (t0 >= 64 ? 1 : 2)) : 5, ihi = lat ? (t0 + 128 < LSEQ ? 4 : (t0 + 64 < LSEQ ? 3 : 2)) : 4;
        const int nloc = lat ? (ihi - ilo + 1) : 0;
        ntiles = nloc + 4; tfirst = ilo;
        const int head = kv * 4 + g;
        const int tq = t0 + qh * 32 + r;
        const bf16* qp = C.P + (size_t)(qrow0 + qh * 32 + r) * INW + CA_Q + head * 64;
        bf16x8 Qf[4];
#pragma unroll
        for (int s = 0; s < 4; ++s) Qf[s] = *(const bf16x8*)(qp + s * 16 + h * 8);
        f32x16 O[2];
#pragma unroll
        for (int mt = 0; mt < 2; ++mt)
#pragma unroll
            for (int i = 0; i < 16; ++i) O[mt][i] = 0.f;
        float ls = 0.f;
        v4u kreg, vreg, kreg2, vreg2;
        auto tile_row = [&](int it) -> int { return it < nloc ? b * LSEQ + t0 + 64 * (tfirst + it - 2) : NLAT + b * LCTX + 64 * (it - nloc); };
        { const bf16* kr = C.P + (size_t)(tile_row(0) + srow) * INW; kreg = *(const v4u*)(kr + CA_K + kv * 64 + sch * 8); vreg = *(const v4u*)(kr + CA_V + kv * 64 + sch * 8); }
        { const bf16* kr = C.P + (size_t)(tile_row(1) + srow) * INW; kreg2 = *(const v4u*)(kr + CA_K + kv * 64 + sch * 8); vreg2 = *(const v4u*)(kr + CA_V + kv * 64 + sch * 8); }
        __syncthreads();
        *(LAS v4u*)(lds + srow * KV_PITCH + sch * 16) = kreg; *(LAS v4u*)(lds + 2 * KV_IMG + srow * KV_PITCH + sch * 16) = vreg;
        kreg = kreg2; vreg = vreg2;
        __syncthreads();
        for (int it = 0; it < ntiles; ++it) {
            const int cur = it & 1;
            if (it + 2 < ntiles) { const bf16* kr = C.P + (size_t)(tile_row(it + 2) + srow) * INW; kreg2 = *(const v4u*)(kr + CA_K + kv * 64 + sch * 8); vreg2 = *(const v4u*)(kr + CA_V + kv * 64 + sch * 8); }
            LAS unsigned char* Kb = lds + cur * KV_IMG; LAS unsigned char* Vb = lds + 2 * KV_IMG + cur * KV_IMG;
            const bool local = it < nloc; const int tk0 = t0 + 64 * (tfirst + it - 2);
            const bool edge = local && (tfirst + it == 0 || tfirst + it == 4);
#pragma unroll
            for (int sub = 0; sub < 2; ++sub) {
                f32x16 S;
#pragma unroll
                for (int i = 0; i < 16; ++i) S[i] = -Mb2;
#pragma unroll
                for (int s = 0; s < 4; ++s) { const bf16x8 kf = *(LAS bf16x8*)(Kb + (32 * sub + r) * KV_PITCH + s * 32 + h * 16); S = MFMA32(kf, Qf[s], S); }
                float t = 0.f;
#pragma unroll
                for (int i = 0; i < 16; ++i) { float e = __builtin_amdgcn_exp2f(S[i]);
                    if (edge) { const int tk = tk0 + 32 * sub + (i & 3) + 8 * (i >> 2) + 4 * h; const int d = tq - tk; e = (d > 128 || d < -128) ? 0.f : e; }
                    S[i] = e; t += e; }
                ls += t;
                const bf16x8 P0 = PACK8(S, 0), P1 = PACK8(S, 1);
#pragma unroll
                for (int mt = 0; mt < 2; ++mt) {
                    const bf16x8 v0 = tr_pair(Vb + (32 * sub) * KV_PITCH + voff + mt * 64);
                    const bf16x8 v1 = tr_pair(Vb + (32 * sub + 16) * KV_PITCH + voff + mt * 64);
                    O[mt] = MFMA32(v0, P0, O[mt]); O[mt] = MFMA32(v1, P1, O[mt]);
                }
            }
            if (it + 1 < ntiles) { *(LAS v4u*)(lds + (cur ^ 1) * KV_IMG + srow * KV_PITCH + sch * 16) = kreg; *(LAS v4u*)(lds + 2 * KV_IMG + (cur ^ 1) * KV_IMG + srow * KV_PITCH + sch * 16) = vreg; kreg = kreg2; vreg = vreg2; }
            __syncthreads();
        }
        ls += shx_(C.lane, ls, 32);
        const float inv = 1.f / (ls + __builtin_amdgcn_exp2f(C.wsink[l * 8 + head] * 1.4426950408889634f - Mb2));
        bf16* op = C.MIX + (size_t)(qrow0 + qh * 32 + r) * 1024 + head * 64;
#pragma unroll
        for (int mt = 0; mt < 2; ++mt)
#pragma unroll
            for (int gg = 0; gg < 4; ++gg) { const int dv0 = 32 * mt + 8 * gg + 4 * h;
                v2u w; w.x = pkbf(O[mt][4 * gg] * inv, O[mt][4 * gg + 1] * inv); w.y = pkbf(O[mt][4 * gg + 2] * inv, O[mt][4 * gg + 3] * inv);
                *(v2u*)(op + dv0) = w; }
    }
}


constexpr size_t WS_DEC = 452 * MiB;
constexpr int HG_IMG = 64 * KV_PITCH;
DI bf16x8 tr_nat(LAS unsigned char* img, int rowbase, int colbase, int lane) {
    const int h = lane >> 5, q4 = (lane & 15) >> 2, p4 = lane & 3, grp = (lane >> 4) & 1;
    LAS unsigned char* p = img + (rowbase + 8 * h + q4) * KV_PITCH + (colbase + 16 * grp + 4 * p4) * 2;
    const s16x4 lo = __builtin_amdgcn_ds_read_tr16_b64_v4i16((LAS s16x4*)p), hi = __builtin_amdgcn_ds_read_tr16_b64_v4i16((LAS s16x4*)(p + 4 * KV_PITCH));
    return __builtin_shufflevector(lo, hi, 0, 1, 2, 3, 4, 5, 6, 7);
}
DI int hg_rowbase(int b, int tc) { return tc < 4 ? NLAT + b * LCTX + 64 * tc : b * LSEQ + 64 * (tc - 4); }
DI int hg_scan_n(int tc, int dir) { return tc < 4 ? (dir ? 3 - tc : tc) : (dir ? 4 + (131 - tc) : tc); }

template <int MODE> DI void hgrn_chunk_phase(const Args& A, int wave_s, int l, bool need_ctx, LAS unsigned char* lds) {
    const Ctx C = make_ctx(A, wave_s);
    const int lane = C.lane, wave = C.wave, dir = wave >> 2, iq = wave & 3, r = lane & 31, h5 = lane >> 5;
    float* DEC = (float*)(C.ws + WS_DEC);
    LAS float* qt = (LAS float*)(lds + 131072);
    LAS unsigned char* img = lds + dir * (5 * HG_IMG);
    LAS float* OX = (LAS float*)(lds + 10 * HG_IMG);
    const int ntc = (MODE == 0 || need_ctx) ? 132 : 128, tc0 = (MODE == 0 || need_ctx) ? 0 : 4;
    const int nunits = 16 * ntc;
    const int kp = lane & 31, e8 = (wave & 3) * 2 + (lane >> 5);
    unsigned npf[8], nv[8], nq[8], nsp[8];
#define HG_UNIT(uu, bh_, tc_, b_, hd_, rbase_, n_, seq_) const int bh_ = (uu) / ntc, tc_ = tc0 + (uu) % ntc, b_ = bh_ >> 2, hd_ = bh_ & 3; \
        const int rbase_ = hg_rowbase(b_, tc_), n_ = hg_scan_n(tc_, dir), seq_ = (dir * 4 + b_) * 4 + hd_;
#define HG_FETCH(uu) do { HG_UNIT(uu, fbh, ftc, fb, fhd, frb, fn, fseq) \
        const int fq_ = (dir ? CB_QB : CB_QF) + fhd * 64 + 2 * kp, ff_ = (dir ? CB_FB : CB_FF) + fhd * 64 + 2 * kp, fi_ = CB_I + fhd * 64 + 2 * kp; \
        _Pragma("unroll") for (int ii = 0; ii < 8; ++ii) { const int i = e8 * 8 + ii; const int row = dir ? frb + 63 - i : frb + i; const bf16* pr_ = C.P + (size_t)row * INW; \
            npf[ii] = *(const unsigned*)(pr_ + ff_); nv[ii] = *(const unsigned*)(pr_ + fi_); nq[ii] = (MODE == 1) ? *(const unsigned*)(pr_ + fq_) : 0u; } \
        if (MODE == 1) { const bf16* sl_ = (const bf16*)C.ST + ((size_t)(fseq * 132 + fn)) * 4096; _Pragma("unroll") for (int ii = 0; ii < 8; ++ii) nsp[ii] = *(const unsigned*)(sl_ + (e8 * 8 + ii) * 64 + 2 * kp); } } while (0)
    if ((int)blockIdx.x < nunits) HG_FETCH((int)blockIdx.x);
    for (int u = blockIdx.x; u < nunits; u += gridDim.x) {
        HG_UNIT(u, bh, tc, b, hd, rbase, n, seq)
        (void)bh; (void)b;
        const float lb0 = C.SM[SM_LOWER + (l * 2 + dir) * 256 + hd * 64 + 2 * kp], lb1 = C.SM[SM_LOWER + (l * 2 + dir) * 256 + hd * 64 + 2 * kp + 1];
        float cum0[8], cum1[8], kk0[8], kk1[8]; float bl0 = 0.f, bl1 = 0.f;
        unsigned vraw[8], qraw[8], spv[8];
#pragma unroll
        for (int ii = 0; ii < 8; ++ii) {
            const float pf0 = __builtin_bit_cast(float, npf[ii] << 16), pf1 = __builtin_bit_cast(float, npf[ii] & 0xffff0000u);
            const float f0 = fmaxf(lb0 + (1.f - lb0) * sigmoid_f(pf0), 1e-30f), f1 = fmaxf(lb1 + (1.f - lb1) * sigmoid_f(pf1), 1e-30f);
            bl0 += __logf(f0); bl1 += __logf(f1); cum0[ii] = bl0; cum1[ii] = bl1; kk0[ii] = 1.f - f0; kk1[ii] = 1.f - f1;
            vraw[ii] = nv[ii]; qraw[ii] = nq[ii]; spv[ii] = nsp[ii]; }
        bf16* SL = (bf16*)C.ST + ((size_t)(seq * 132 + n)) * 4096;
        if (u + (int)gridDim.x < nunits) HG_FETCH(u + (int)gridDim.x);
        __syncthreads();
        LAS fv2* qt2 = (LAS fv2*)qt;
        qt2[(dir * 8 + e8) * 32 + kp] = (fv2){bl0, bl1};
        __syncthreads();
        float off0 = 0.f, off1 = 0.f, bref0 = 0.f, bref1 = 0.f, bend0 = 0.f, bend1 = 0.f;
#pragma unroll
        for (int j = 0; j < 8; ++j) { const fv2 tq = qt2[(dir * 8 + j) * 32 + kp];
            if (j < e8) { off0 += tq.x; off1 += tq.y; }
            if (j < 4) { bref0 += tq.x; bref1 += tq.y; }
            bend0 += tq.x; bend1 += tq.y; }
#pragma unroll
        for (int ii = 0; ii < 8; ++ii) { const int i = e8 * 8 + ii; const float bi0 = off0 + cum0[ii], bi1 = off1 + cum1[ii];
            if (MODE == 0) {
                *(LAS unsigned*)(img + i * KV_PITCH + kp * 4) = pk2(kk0[ii] * __expf(bend0 - bi0), kk1[ii] * __expf(bend1 - bi1));
                *(LAS unsigned*)(img + HG_IMG + i * KV_PITCH + kp * 4) = vraw[ii];
            } else {
                const float q0 = __builtin_bit_cast(float, qraw[ii] << 16), q1 = __builtin_bit_cast(float, qraw[ii] & 0xffff0000u);
                *(LAS unsigned*)(img + i * KV_PITCH + kp * 4) = pk2(q0 * __expf(fminf(bi0 - bref0, 80.f)), q1 * __expf(fminf(bi1 - bref1, 80.f)));
                *(LAS unsigned*)(img + HG_IMG + i * KV_PITCH + kp * 4) = pk2(kk0[ii] * __expf(fminf(bref0 - bi0, 80.f)), kk1[ii] * __expf(fminf(bref1 - bi1, 80.f)));
                *(LAS unsigned*)(img + 2 * HG_IMG + i * KV_PITCH + kp * 4) = pk2(q0 * __expf(bi0), q1 * __expf(bi1));
                *(LAS unsigned*)(img + 3 * HG_IMG + i * KV_PITCH + kp * 4) = vraw[ii];
            }
        }
        if (MODE == 0) { if (e8 == 0) *(fv2*)(DEC + (seq * 132 + n) * 64 + 2 * kp) = (fv2){__expf(bend0), __expf(bend1)}; }
        else {
#pragma unroll
            for (int ii = 0; ii < 8; ++ii) { const int k = e8 * 8 + ii; *(LAS unsigned*)(img + 4 * HG_IMG + k * KV_PITCH + kp * 4) = spv[ii]; }
        }
        __syncthreads();
        if (MODE == 0) {
            const int kblk = (wave >> 1) & 1, dvblk = wave & 1;
            f32x16 S;
#pragma unroll
            for (int i = 0; i < 16; ++i) S[i] = 0.f;
#pragma unroll
            for (int is = 0; is < 4; ++is) { const bf16x8 a = tr_nat(img, 16 * is, 32 * kblk, lane), bb = tr_nat(img + HG_IMG, 16 * is, 32 * dvblk, lane); S = MFMA32(a, bb, S); }
#pragma unroll
            for (int i = 0; i < 16; ++i) { const int k = 32 * kblk + (i & 3) + 8 * (i >> 2) + 4 * h5; SL[k * 64 + 32 * dvblk + r] = (bf16)f2bf(S[i]); }
        } else {
            const int tblk = (wave >> 1) & 1, mt = wave & 1;
            LAS unsigned char* QP = img; LAS unsigned char* KP = img + HG_IMG; LAS unsigned char* QQ = img + 2 * HG_IMG; LAS unsigned char* VI = img + 3 * HG_IMG; LAS unsigned char* SP = img + 4 * HG_IMG;
            const int q4 = (lane & 15) >> 2, p4 = lane & 3, grp = (lane >> 4) & 1;
            const int voff = (4 * h5 + q4) * KV_PITCH + (16 * grp + 4 * p4) * 2;
            f32x16 O;
#pragma unroll
            for (int i = 0; i < 16; ++i) O[i] = 0.f;
#pragma unroll
            for (int sblk = 0; sblk < 2; ++sblk) {
                if (sblk <= tblk) {
                    f32x16 AT;
#pragma unroll
                    for (int i = 0; i < 16; ++i) AT[i] = 0.f;
#pragma unroll
                    for (int ks = 0; ks < 4; ++ks) { const bf16x8 a = *(LAS bf16x8*)(KP + (32 * sblk + r) * KV_PITCH + ks * 32 + h5 * 16), bq = *(LAS bf16x8*)(QP + (32 * tblk + r) * KV_PITCH + ks * 32 + h5 * 16); AT = MFMA32(a, bq, AT); }
                    if (sblk == tblk) {
#pragma unroll
                        for (int i = 0; i < 16; ++i) { const int sp = (i & 3) + 8 * (i >> 2) + 4 * h5; AT[i] = (sp <= r) ? AT[i] : 0.f; }
                    }
                    const bf16x8 P0 = PACK8(AT, 0), P1 = PACK8(AT, 1);
                    const bf16x8 v0 = tr_pair(VI + (32 * sblk) * KV_PITCH + voff + mt * 64), v1 = tr_pair(VI + (32 * sblk + 16) * KV_PITCH + voff + mt * 64);
                    O = MFMA32(v0, P0, O); O = MFMA32(v1, P1, O);
                }
            }
#pragma unroll
            for (int ks = 0; ks < 4; ++ks) { const bf16x8 a = tr_nat(SP, 16 * ks, 32 * mt, lane), bq = *(LAS bf16x8*)(QQ + (32 * tblk + r) * KV_PITCH + ks * 32 + h5 * 16); O = MFMA32(a, bq, O); }
            const int pos = 32 * tblk + r, tloc = dir ? 63 - pos : pos;
#pragma unroll
            for (int i = 0; i < 16; ++i) { const int dv = 32 * mt + (i & 3) + 8 * (i >> 2) + 4 * h5; OX[(dir * 64 + tloc) * 68 + dv] = O[i]; }
            __syncthreads();
            {
                const int t = C.tid >> 3, part = C.tid & 7; const int row = rbase + t;
                float tot[8]; float ss = 0.f;
#pragma unroll
                for (int e = 0; e < 8; ++e) { tot[e] = OX[t * 68 + part * 8 + e] + OX[(64 + t) * 68 + part * 8 + e]; ss += tot[e] * tot[e]; }
                ss += shx_(C.lane, ss, 1); ss += shx_(C.lane, ss, 2); ss += shx_(C.lane, ss, 4);
                const float rs = rsqrtf(ss * (1.f / 64.f) + EPS);
                const v4u gr = *(const v4u*)(C.P + (size_t)row * INW + CB_G + hd * 64 + part * 8);
                unsigned res[4];
#pragma unroll
                for (int q = 0; q < 4; ++q) { const float g0 = __builtin_bit_cast(float, gr[q] << 16), g1 = __builtin_bit_cast(float, gr[q] & 0xffff0000u);
                    const float y0 = tot[2 * q] * rs * C.hgog[l * 64 + part * 8 + 2 * q] * silu_f(g0), y1 = tot[2 * q + 1] * rs * C.hgog[l * 64 + part * 8 + 2 * q + 1] * silu_f(g1);
                    res[q] = pkbf(y0, y1); }
                v4u o; o.x = res[0]; o.y = res[1]; o.z = res[2]; o.w = res[3];
                *(v4u*)(C.MIX + (size_t)row * 1024 + 512 + hd * 64 + part * 8) = o;
            }
        }
    }
    __syncthreads();
}
DI void hgrn_scan_phase(const Args& A, int wave_s) {
    const Ctx C = make_ctx(A, wave_s);
    const float* DEC = (const float*)(C.ws + WS_DEC);
    for (int gid = blockIdx.x * 512 + C.tid; gid < 32 * 2048; gid += gridDim.x * 512) {
        const int seq = gid >> 11, e = gid & 2047, k = e >> 5;
        unsigned* SL = (unsigned*)C.ST + (size_t)seq * 132 * 2048 + e; const float* D = DEC + seq * 132 * 64 + k;
        float s0 = 0.f, s1 = 0.f;
        for (int n = 0; n < 132; n += 12) {
            unsigned sl[12]; float d[12];
#pragma unroll
            for (int j = 0; j < 12; ++j) { sl[j] = SL[(size_t)(n + j) * 2048]; d[j] = D[(n + j) * 64]; }
#pragma unroll
            for (int j = 0; j < 12; ++j) { SL[(size_t)(n + j) * 2048] = pk2(s0, s1);
                s0 = d[j] * s0 + __builtin_bit_cast(float, sl[j] << 16); s1 = d[j] * s1 + __builtin_bit_cast(float, sl[j] & 0xffff0000u); }
        }
    }
}

DI void conv_phase(const Args& A, int wave_s, int l, int j, int rows) {
    const Ctx C = make_ctx(A, wave_s);
    const float* cw = C.conv_w + (size_t)l * 3 * 5632; const float* cb = C.conv_b + (size_t)l * 5632;
    const int total = rows * 176;
    for (int e = blockIdx.x * 512 + C.tid; e < total; e += gridDim.x * 512) {
        const int m = e / 176, c8 = (e % 176) * 8;
        bool first, last;
        if (m < NLAT) { first = (m & 8191) == 0; last = (m & 8191) == 8191; } else { first = ((m - NLAT) & 255) == 0; last = ((m - NLAT) & 255) == 255; }
        const bf16* u1 = C.U + (size_t)m * DFF;
        v4u z = {0u, 0u, 0u, 0u};
        const v4u a0 = first ? z : *(const v4u*)(u1 - DFF + c8), a1 = *(const v4u*)(u1 + c8), a2 = last ? z : *(const v4u*)(u1 + DFF + c8);
        const v4u b0 = first ? z : *(const v4u*)(u1 - DFF + DFFH + c8), b1 = *(const v4u*)(u1 + DFFH + c8), b2 = last ? z : *(const v4u*)(u1 + DFF + DFFH + c8);
        const int na = j * DFFH + c8, nv = DFF + j * DFFH + c8;
        unsigned res[4];
#pragma unroll
        for (int q = 0; q < 4; ++q) {
            float r2[2];
#pragma unroll
            for (int hlf = 0; hlf < 2; ++hlf) {
                const int i = 2 * q + hlf;
                const float ua0 = hlf ? __builtin_bit_cast(float, a0[q] & 0xffff0000u) : __builtin_bit_cast(float, a0[q] << 16);
                const float ua1 = hlf ? __builtin_bit_cast(float, a1[q] & 0xffff0000u) : __builtin_bit_cast(float, a1[q] << 16);
                const float ua2 = hlf ? __builtin_bit_cast(float, a2[q] & 0xffff0000u) : __builtin_bit_cast(float, a2[q] << 16);
                const float ub0 = hlf ? __builtin_bit_cast(float, b0[q] & 0xffff0000u) : __builtin_bit_cast(float, b0[q] << 16);
                const float ub1 = hlf ? __builtin_bit_cast(float, b1[q] & 0xffff0000u) : __builtin_bit_cast(float, b1[q] << 16);
                const float ub2 = hlf ? __builtin_bit_cast(float, b2[q] & 0xffff0000u) : __builtin_bit_cast(float, b2[q] << 16);
                const float ya = cb[na + i] + ua0 * cw[na + i] + ua1 * cw[5632 + na + i] + ua2 * cw[2 * 5632 + na + i];
                const float yv = cb[nv + i] + ub0 * cw[nv + i] + ub1 * cw[5632 + nv + i] + ub2 * cw[2 * 5632 + nv + i];
                r2[hlf] = silu_f(ya) * yv;
            }
            res[q] = pk2(r2[0], r2[1]);
        }
        v4u o; o.x = res[0]; o.y = res[1]; o.z = res[2]; o.w = res[3];
        *(v4u*)(C.ACT + (size_t)m * DFFH + c8) = o;
    }
}


DI void ffn_fixup_phase(const Args& A, int wave_s, int l, int rows) {
    const Ctx C = make_ctx(A, wave_s);
    const float* cw = C.conv_w + (size_t)l * 3 * 5632; const float* cb = C.conv_b + (size_t)l * 5632;
    const bf16* UB = C.ACT;
    bf16* ACTF = C.U;
    const int nkb = rows / 64, total = nkb * 2 * 352;
    for (int e = blockIdx.x * 512 + C.tid; e < total; e += gridDim.x * 512) {
        const int c8 = (e % 352) * 8, rs = e / 352, side = rs & 1, kb = rs >> 1;
        const int R = kb * 64 + (side ? 63 : 0);
        bool first, last;
        if (R < NLAT) { first = (R & 8191) == 0; last = (R & 8191) == 8191; } else { first = ((R - NLAT) & 255) == 0; last = ((R - NLAT) & 255) == 255; }
        const v4u z = {0u, 0u, 0u, 0u};
        const bf16* pp = side ? UB + (size_t)((kb * 4 + 2) * 2) * 2816 : UB + (size_t)(((kb - 1) * 4 + 3) * 2) * 2816;
        const bf16* pc = UB + (size_t)((kb * 4 + (side ? 3 : 0)) * 2) * 2816;
        const bf16* pn = side ? UB + (size_t)(((kb + 1) * 4 + 0) * 2) * 2816 : UB + (size_t)((kb * 4 + 1) * 2) * 2816;
        const bool zp = (!side) && first, zn = side && last;
        const v4u a0 = zp ? z : *(const v4u*)(pp + c8), a1 = *(const v4u*)(pc + c8), a2 = zn ? z : *(const v4u*)(pn + c8);
        const v4u b0 = zp ? z : *(const v4u*)(pp + 2816 + c8), b1 = *(const v4u*)(pc + 2816 + c8), b2 = zn ? z : *(const v4u*)(pn + 2816 + c8);
        unsigned res[4];
#pragma unroll
        for (int q = 0; q < 4; ++q) {
            float r2[2];
#pragma unroll
            for (int hlf = 0; hlf < 2; ++hlf) {
                const int i = c8 + 2 * q + hlf;
                const float ua0 = hlf ? __builtin_bit_cast(float, a0[q] & 0xffff0000u) : __builtin_bit_cast(float, a0[q] << 16);
                const float ua1 = hlf ? __builtin_bit_cast(float, a1[q] & 0xffff0000u) : __builtin_bit_cast(float, a1[q] << 16);
                const float ua2 = hlf ? __builtin_bit_cast(float, a2[q] & 0xffff0000u) : __builtin_bit_cast(float, a2[q] << 16);
                const float ub0 = hlf ? __builtin_bit_cast(float, b0[q] & 0xffff0000u) : __builtin_bit_cast(float, b0[q] << 16);
                const float ub1 = hlf ? __builtin_bit_cast(float, b1[q] & 0xffff0000u) : __builtin_bit_cast(float, b1[q] << 16);
                const float ub2 = hlf ? __builtin_bit_cast(float, b2[q] & 0xffff0000u) : __builtin_bit_cast(float, b2[q] << 16);
                const float ya = cb[i] + ua0 * cw[i] + ua1 * cw[5632 + i] + ua2 * cw[2 * 5632 + i];
                const float yv = cb[2816 + i] + ub0 * cw[2816 + i] + ub1 * cw[5632 + 2816 + i] + ub2 * cw[2 * 5632 + 2816 + i];
                r2[hlf] = silu_f(ya) * yv;
            }
            res[q] = pk2(r2[0], r2[1]);
        }
        v4u o; o.x = res[0]; o.y = res[1]; o.z = res[2]; o.w = res[3];
        *(v4u*)(ACTF + (size_t)R * 2816 + c8) = o;
    }
}

typedef __attribute__((address_space(1))) unsigned gu32;
#define RLX_AGENT __ATOMIC_RELAXED, __HIP_MEMORY_SCOPE_AGENT
#define LDS_WAIT() asm volatile("s_waitcnt lgkmcnt(0)" ::: "memory")
#define VM_WAIT() asm volatile("s_waitcnt vmcnt(0)" ::: "memory")
#define XB_TMO      128
#define XB_XCNT(j)  (256  + 64 * (j))
#define XB_XSUB(j)  (1280 + 64 * (j))
#define XB_XGEN(j)  (2304 + 64 * (j))
#define XB_TOP      3328
#define XB_TOPGEN   3392
#define XCD_BAR_WORDS 3456
#define XB_SPIN_CAP (1u << 18)

__device__ __forceinline__ unsigned xb_ld(unsigned* p)              { return __hip_atomic_load(p, __ATOMIC_RELAXED, __HIP_MEMORY_SCOPE_AGENT); }
__device__ __forceinline__ unsigned xb_add(unsigned* p, unsigned v) { return __hip_atomic_fetch_add(p, v, __ATOMIC_RELAXED, __HIP_MEMORY_SCOPE_AGENT); }
__device__ __forceinline__ unsigned xb_xcc_id() { return (unsigned)__builtin_amdgcn_s_getreg((3 << 11) | 20) & 0xFu; }
#define XB_SPIN(cond, bar) do { unsigned _sp = 0; while (cond) { __builtin_amdgcn_s_sleep(1); \
    if ((++_sp & 255u) == 0u) { if (xb_ld(&(bar)[XB_TMO])) break; if (_sp > XB_SPIN_CAP) { atomicAdd(&(bar)[XB_TMO], 1u); break; } } } } while (0)

struct XcdBarrier {
    unsigned* bar; unsigned x;
    volatile LAS unsigned* st;
};

__device__ __forceinline__ XcdBarrier xcd_barrier_post(unsigned* bar, volatile LAS unsigned* st, int xtid) {
    XcdBarrier b; b.bar = bar; b.x = xb_xcc_id(); b.st = st;
    if (xtid == 0) (void)xb_add(&bar[XB_XCNT(b.x)], 1u);
    return b;
}
__device__ __forceinline__ void xcd_barrier_complete(unsigned* bar, unsigned x, unsigned& nloc, unsigned& nx) {
    const unsigned G = gridDim.x * gridDim.y * gridDim.z;
    unsigned sum, cnt, mine, sp = 0u;
    for (;;) {
        sum = 0u; cnt = 0u; mine = 0u;
#pragma unroll
        for (unsigned j = 0; j < 16; ++j) { const unsigned c = xb_ld(&bar[XB_XCNT(j)]); sum += c; cnt += (c > 0u) ? 1u : 0u; mine = (j == x) ? c : mine; }
        if (sum == G) break;
        __builtin_amdgcn_s_sleep(1);
        if ((++sp & 255u) == 0u) { if (xb_ld(&bar[XB_TMO])) break; if (sp > XB_SPIN_CAP) { atomicAdd(&bar[XB_TMO], 1u); break; } }
    }
    nloc = mine > 0u ? mine : 1u; nx = cnt > 0u ? cnt : 1u;
}

__device__ __forceinline__ void xcd_barrier(const XcdBarrier& b, int xtid) {
    asm volatile("s_waitcnt vmcnt(0)" ::: "memory");
    __syncthreads();
    if (xtid == 0) {
        unsigned* bar = b.bar; unsigned bx_ = b.x; asm volatile("" : "+s"(bx_));
        __builtin_amdgcn_s_waitcnt(0);
        unsigned nloc = b.st[0], nx = b.st[1];
        if (nloc == 0u) { xcd_barrier_complete(bar, bx_, nloc, nx); b.st[0] = nloc; b.st[1] = nx; }
        const unsigned old = xb_add(&bar[XB_XSUB(bx_)], 1u);
        const unsigned gen = old / nloc;
        if (old + 1u == (gen + 1u) * nloc) {
            __builtin_amdgcn_fence(__ATOMIC_RELEASE, "agent");
            asm volatile("s_waitcnt vmcnt(0)" ::: "memory");
            const unsigned og = xb_add(&bar[XB_TOP], 1u);
            const unsigned tg = og / nx;
            if (og + 1u == (tg + 1u) * nx) xb_add(&bar[XB_TOPGEN], 1u);
            else XB_SPIN(xb_ld(&bar[XB_TOPGEN]) == tg, bar);
            __builtin_amdgcn_fence(__ATOMIC_ACQUIRE, "agent");
            xb_add(&bar[XB_XGEN(bx_)], 1u);
            asm volatile("s_waitcnt vmcnt(0)" ::: "memory");
        } else {
            XB_SPIN(xb_ld(&bar[XB_XGEN(bx_)]) == gen, bar);
            __builtin_amdgcn_fence(__ATOMIC_ACQUIRE, "agent");
            asm volatile("s_waitcnt vmcnt(0)" ::: "memory");
        }
    }
    __syncthreads();
}

#if PROBE_SYNC2
#define GSYNC() do { xcd_barrier(xbar, wave_s * 64 + fresh_lane()); xcd_barrier(xbar, wave_s * 64 + fresh_lane()); } while (0)
#else
#define GSYNC() xcd_barrier(xbar, wave_s * 64 + fresh_lane())
#endif
__global__ void __launch_bounds__(512, 2) fwd_kernel(Args args) {
    extern __shared__ __attribute__((aligned(16))) unsigned char lds_raw[];
    LAS unsigned char* lds = (LAS unsigned char*)lds_raw;
    cg::grid_group grid = cg::this_grid();
    const int G = gridDim.x, bx = blockIdx.x;

    if (threadIdx.x < 4) ((volatile LAS unsigned*)(lds + 139264))[threadIdx.x] = 0u;
    __syncthreads();
    const int wave_s = __builtin_amdgcn_readfirstlane(threadIdx.x >> 6);
    XcdBarrier xbar = xcd_barrier_post((unsigned*)args.ws + 1024, (volatile LAS unsigned*)(lds + 139264), (int)threadIdx.x);
    p0_phase(args, wave_s, lds);
    p0_transposes(args, wave_s, lds, 0, 1536, bx * 8 + wave_s, G * 8);
    grid.sync();
    for (int l = 0; l < 2; ++l) {
        const bool need_ctx = (l == 0);
        const int Mres = need_ctx ? MTOT : NLAT;
        norm_phase(args, wave_s, l, 1, MTOT);
#if PROBE_EW2
        norm_phase(args, wave_s, l, 1, MTOT);
#endif
        GSYNC();
        { pg8::Gemm g{(const bf16*)(args.ws + WS_H), (const bf16*)(args.ws + WS_WIN) + (size_t)l * 3072 * 1024, MTOT, INW, 1024}; pg8::StaticOrder S; S.init(MTOT, INW, G, bx);
          pg8::EpiBf16 E{(bf16*)(args.ws + WS_P), INW}; pg8::gemm_phase<pg8::EpiBf16, pg8::StaticOrder, true, true>(lds, g, S, E, wave_s * 64 + fresh_lane());
#if PROBE_IN2
          pg8::gemm_phase<pg8::EpiBf16, pg8::StaticOrder, true, true>(lds, g, S, E, wave_s * 64 + fresh_lane());
#endif
          if (l == 0 && bx >= (1584 % G)) p0_transposes(args, wave_s, lds, 1536, 12544, (bx - 1584 % G) * 8 + wave_s, (G - 1584 % G) * 8);
#if PROBE_GEMM2
          pg8::gemm_phase<pg8::EpiBf16, pg8::StaticOrder, true, true>(lds, g, S, E, wave_s * 64 + fresh_lane());
#endif
        }
        GSYNC();
        prep_phase(args, wave_s, l);
        hgrn_chunk_phase<0>(args, wave_s, l, need_ctx, lds);
        GSYNC();
        hgrn_scan_phase(args, wave_s);
        win_mfma_phase(args, wave_s, l, need_ctx, lds);
        GSYNC();
        hgrn_chunk_phase<1>(args, wave_s, l, need_ctx, lds);
        diff_mfma_phase(args, wave_s, l, need_ctx, lds);
        GSYNC();
        { pg8::Gemm g{(const bf16*)(args.ws + WS_MIX), (const bf16*)(args.ws + WS_WOUT) + (size_t)l * 1024 * 1024, Mres, 1024, 1024}; pg8::StaticOrder S; S.init(Mres, 1024, G, bx);
          pg8::EpiResGate E{l == 0 ? args.in[0] : args.out, l == 0 ? args.in[2] : (const float*)(args.ws + WS_XC), args.out, (float*)(args.ws + WS_XC), (const float*)(args.ws + WS_SMALL) + SM_MOD + l * 5 * 6144 + 2048};
          pg8::gemm_phase<pg8::EpiResGate, pg8::StaticOrder, true, true>(lds, g, S, E, wave_s * 64 + fresh_lane()); }
        GSYNC();
        norm_phase(args, wave_s, l, 2, Mres);
#if PROBE_EW2
        norm_phase(args, wave_s, l, 2, Mres);
#endif
        GSYNC();
        { pg8::Gemm g{(const bf16*)(args.ws + WS_H), (const bf16*)(args.ws + WS_WUP) + (size_t)l * 5632 * 1024, Mres, 5632, 1024}; pg8::StaticOrder S; S.init(Mres, 5632, G, bx);
          pg8::EpiConvGate E{(bf16*)(args.ws + WS_U), (bf16*)(args.ws + WS_ACT), args.in[20] + (size_t)l * 3 * 5632, args.in[21] + (size_t)l * 5632};
          pg8::gemm_phase<pg8::EpiConvGate, pg8::StaticOrder, true, true>(lds, g, S, E, wave_s * 64 + fresh_lane());
#if PROBE_UP2
          pg8::gemm_phase<pg8::EpiConvGate, pg8::StaticOrder, true, true>(lds, g, S, E, wave_s * 64 + fresh_lane());
#endif
        }
        GSYNC();
        ffn_fixup_phase(args, wave_s, l, Mres);
        GSYNC();
        { pg8::Gemm g{(const bf16*)(args.ws + WS_U), (const bf16*)(args.ws + WS_WDN) + (size_t)l * 2816 * 1024, Mres, 1024, DFF}; pg8::StaticOrder S; S.init(Mres, 1024, G, bx);
          pg8::EpiResGate E{args.out, (const float*)(args.ws + WS_XC), args.out, (float*)(args.ws + WS_XC), (const float*)(args.ws + WS_SMALL) + SM_MOD + l * 5 * 6144 + 5120};
          pg8::gemm_phase<pg8::EpiResGate, pg8::StaticOrder, true, true>(lds, g, S, E, wave_s * 64 + fresh_lane()); }
        GSYNC();
    }
}

extern "C" void kernel_launch(void* const* d_in, const int* in_sizes, int n_in, void* d_out, int out_size, void* d_ws, size_t ws_size, hipStream_t stream) {
    static int grid = 0;
    if (grid == 0) {
        if (n_in != 23 || ws_size < WS_END) { fprintf(stderr, "kernel_launch: bad args n_in %d ws %zu\n", n_in, ws_size); grid = -1; return; }
        int dev = 0, cus = 0, per_cu = 0;
        (void)hipGetDevice(&dev); (void)hipDeviceGetAttribute(&cus, hipDeviceAttributeMultiprocessorCount, dev);
        (void)hipFuncSetAttribute((const void*)fwd_kernel, hipFuncAttributeMaxDynamicSharedMemorySize, LDS_BYTES);
        (void)hipOccupancyMaxActiveBlocksPerMultiprocessor(&per_cu, (const void*)fwd_kernel, 512, LDS_BYTES);
        if (per_cu < 1) per_cu = 1;
        grid = cus;
        (void)hipGetLastError();
    }
    if (grid < 0) return;
    if (hipMemsetAsync(d_ws, 0, 65536, stream) != hipSuccess) { fprintf(stderr, "memset failed\n"); return; }
    Args a{};
    for (int i = 0; i < 23; ++i) a.in[i] = (const float*)d_in[i];
    a.out = (float*)d_out; a.ws = (unsigned char*)d_ws;
    void* params[] = {&a};
    hipError_t e = hipLaunchCooperativeKernel((const void*)fwd_kernel, dim3(grid), dim3(512), params, LDS_BYTES, stream);
    if (e != hipSuccess) fprintf(stderr, "cooperative launch failed: %s (grid %d)\n", hipGetErrorString(e), grid);
}
```

```cpp
#include <hip/hip_runtime.h>
#include <hip/hip_cooperative_groups.h>
#include <cstdio>
#include <cstdint>
namespace cg = cooperative_groups;
#ifndef PROBE_DIFF2
#define PROBE_DIFF2 0
#endif
#ifndef PROBE_WIN2
#define PROBE_WIN2 0
#endif
#ifndef PROBE_SYNC2
#define PROBE_SYNC2 0
#endif
#ifndef PROBE_GEMM2
#define PROBE_GEMM2 0
#endif
#ifndef PROBE_HG2
#define PROBE_HG2 0
#endif
#ifndef PROBE_EW2
#define PROBE_EW2 0
#endif
#ifndef PROBE_P02
#define PROBE_P02 0
#endif
#ifndef PROBE_IN2
#define PROBE_IN2 0
#endif
#ifndef PROBE_UP2
#define PROBE_UP2 0
#endif
namespace pg8 {
#define PG8_LAS __attribute__((address_space(3)))
typedef unsigned short bf16_t;
typedef short bf16x8 __attribute__((ext_vector_type(8)));
typedef float f32x4 __attribute__((ext_vector_type(4)));
typedef unsigned u32x4 __attribute__((ext_vector_type(4)));
constexpr int BM = 256, BK = 64, HALF = 128, HTB = HALF * BK * 2  , STAGE_BYTES = 8 * HTB, NXCD = 8, WGM = 8;

__host__ __device__ __forceinline__ int lds_byte(int r, int c) { const int st = (r >> 4) * 2 + (c >> 5), rr = r & 15, cc = c & 31, ob = rr * 64 + cc * 2; return st * 1024 + (ob ^ (((ob >> 9) & 1) << 5)); }
__host__ __device__ __forceinline__ void stage_rc(int b, int& R, int& C) { const int st = b / 1024, sb = b % 1024, swz = sb ^ (((sb >> 9) & 1) << 5); R = (st >> 1) * 16 + swz / 64; C = (st & 1) * 32 + (swz % 64) / 2; }
__host__ __device__ __forceinline__ int perm32(int rho) { const int n = rho >> 4, i = rho & 15; return 8 * (i >> 2) + 4 * n + (i & 3); }

struct Unit { int pm, pn; };
struct Gemm { const bf16_t* A; const bf16_t* Bt; int M, N, K; };

struct StaticOrder {
    int nM, nN, nwg, G, c;
    __host__ __device__ void init(int M, int N, int G_, int c_) { nM = M / BM; nN = N / BM; nwg = nM * nN; G = G_; c = c_; }
    __host__ __device__ bool next(int i, Unit& u) const {
        const long L = (long)i * G + c; if (L >= nwg) return false;
        int wgid = (int)L; { const int q = nwg / NXCD, r = nwg % NXCD, xcd = wgid % NXCD, off = wgid / NXCD; wgid = (xcd < r ? xcd * (q + 1) : r * (q + 1) + (xcd - r) * q) + off; }
        const int nig = WGM * nN, gid = wgid / nig, fm = gid * WGM, gsz = (nM - fm) < WGM ? (nM - fm) : WGM;
        u.pm = fm + ((wgid % nig) % gsz); u.pn = (wgid % nig) / gsz; return true;
    }
    __device__ __forceinline__ void a_ready(const Unit&) const {}
    __device__ __forceinline__ void done(const Unit&) const {}
};

__device__ __forceinline__ unsigned cvt_pk_bf16(float lo, float hi) { unsigned r; asm volatile("v_cvt_pk_bf16_f32 %0, %1, %2" : "=v"(r) : "v"(lo), "v"(hi)); return r; }
typedef unsigned u32x2 __attribute__((ext_vector_type(2)));
struct EpiBf16 {
    static constexpr bool PERM = true, AFTER_DRAIN = false, APERM = false;
    bf16_t* O; int ldc;
    __device__ __forceinline__ void operator()(const f32x4 (&acc)[2][2][4][2], const Unit& u, int wr, int wc, int fr, int fq) const {
        const int row0 = u.pm * BM + wr * 64 + fr; const int col0 = u.pn * BM + wc * 32 + 8 * fq;
#pragma unroll
        for (int ai = 0; ai < 2; ++ai)
#pragma unroll
            for (int m = 0; m < 4; ++m) { bf16_t* rowp = O + (size_t)(row0 + ai * HALF + m * 16) * ldc + col0;
#pragma unroll
                for (int bj = 0; bj < 2; ++bj) { const f32x4 v0 = acc[ai][bj][m][0], v1 = acc[ai][bj][m][1];
                    u32x4 w; w.x = cvt_pk_bf16(v0[0], v0[1]); w.y = cvt_pk_bf16(v0[2], v0[3]); w.z = cvt_pk_bf16(v1[0], v1[1]); w.w = cvt_pk_bf16(v1[2], v1[3]);
                    *(u32x4*)(rowp + bj * HALF) = w; } }
    }
};
struct EpiResGate {
    static constexpr bool PERM = false, AFTER_DRAIN = false, APERM = false;
    const float* base_lat; const float* base_ctx; float* out_lat; float* out_ctx; const float* gate;
    __device__ __forceinline__ void operator()(const f32x4 (&acc)[2][2][4][2], const Unit& u, int wr, int wc, int fr, int fq) const {
        const bool isctx = u.pm >= 128;
        const int v = isctx ? 4 : (u.pm >> 5);
        const float* bp = isctx ? base_ctx - (size_t)32768 * 1024 : base_lat;
        float* op = isctx ? out_ctx - (size_t)32768 * 1024 : out_lat;
        const float* g = gate + v * 6144;
        const int row0 = u.pm * BM + wr * 64 + fr; const int col0 = u.pn * BM + wc * 32 + 4 * fq;
        f32x4 gv[2][2];
#pragma unroll
        for (int bj = 0; bj < 2; ++bj)
#pragma unroll
            for (int n = 0; n < 2; ++n) gv[bj][n] = *(const f32x4*)(g + col0 + bj * HALF + n * 16);
#pragma unroll
        for (int ai = 0; ai < 2; ++ai) {
            f32x4 bs[4][2][2];
#pragma unroll
            for (int m = 0; m < 4; ++m) { const size_t off = (size_t)(row0 + ai * HALF + m * 16) * 1024 + col0;
#pragma unroll
                for (int bj = 0; bj < 2; ++bj)
#pragma unroll
                    for (int n = 0; n < 2; ++n) bs[m][bj][n] = *(const f32x4*)(bp + off + bj * HALF + n * 16); }
#pragma unroll
            for (int m = 0; m < 4; ++m) { const size_t off = (size_t)(row0 + ai * HALF + m * 16) * 1024 + col0;
#pragma unroll
                for (int bj = 0; bj < 2; ++bj)
#pragma unroll
                    for (int n = 0; n < 2; ++n) *(f32x4*)(op + off + bj * HALF + n * 16) = bs[m][bj][n] + gv[bj][n] * acc[ai][bj][m][n]; }
            asm volatile("" ::: "memory");
        }
    }
};
__device__ __forceinline__ float dpp_ror1(float v) { return __builtin_bit_cast(float, __builtin_amdgcn_update_dpp(0, __builtin_bit_cast(int, v), 0x121, 0xF, 0xF, false)); }
__device__ __forceinline__ float dpp_ror15(float v) { return __builtin_bit_cast(float, __builtin_amdgcn_update_dpp(0, __builtin_bit_cast(int, v), 0x12F, 0xF, 0xF, false)); }
struct EpiConvGate {
    static constexpr bool PERM = true, AFTER_DRAIN = false, APERM = true;
    bf16_t* ACT; bf16_t* UB; const float* cw; const float* cb;
    __device__ __forceinline__ void operator()(const f32x4 (&acc)[2][2][4][2], const Unit& u, int wr, int wc, int fr, int fq) const {
        const int chb = u.pn * 128 + wc * 32 + 8 * fq;
        const bool f0 = fr == 0, f15 = fr == 15;
#pragma unroll
        for (int n = 0; n < 2; ++n) {
            const int ch = chb + 4 * n;
            const f32x4 w0a = *(const f32x4*)(cw + ch), w1a = *(const f32x4*)(cw + 5632 + ch), w2a = *(const f32x4*)(cw + 2 * 5632 + ch), ba = *(const f32x4*)(cb + ch);
            const f32x4 w0v = *(const f32x4*)(cw + 2816 + ch), w1v = *(const f32x4*)(cw + 5632 + 2816 + ch), w2v = *(const f32x4*)(cw + 2 * 5632 + 2816 + ch), bv = *(const f32x4*)(cb + 2816 + ch);
#pragma unroll
            for (int ai = 0; ai < 2; ++ai) {
                const int kb = u.pm * 4 + ai * 2 + wr;
                f32x4 pa0, pv0, na3, nv3;
#pragma unroll
                for (int e = 0; e < 4; ++e) { pa0[e] = dpp_ror1(acc[ai][0][3][n][e]); pv0[e] = dpp_ror1(acc[ai][1][3][n][e]); na3[e] = dpp_ror15(acc[ai][0][0][n][e]); nv3[e] = dpp_ror15(acc[ai][1][0][n][e]); }
#pragma unroll
                for (int m = 0; m < 4; ++m) {
                    const f32x4 ua = acc[ai][0][m][n], uv = acc[ai][1][m][n];
                    const f32x4 pa = (m > 0) ? acc[ai][0][m - 1][n] : pa0, na = (m < 3) ? acc[ai][0][m + 1][n] : na3;
                    const f32x4 pv = (m > 0) ? acc[ai][1][m - 1][n] : pv0, nv = (m < 3) ? acc[ai][1][m + 1][n] : nv3;
                    const f32x4 ya = ba + w0a * pa + w1a * ua + w2a * na, yv = bv + w0v * pv + w1v * uv + w2v * nv;
                    f32x4 o;
#pragma unroll
                    for (int e = 0; e < 4; ++e) o[e] = ya[e] * __builtin_amdgcn_rcpf(1.f + __builtin_amdgcn_exp2f(-1.4426950408889634f * ya[e])) * yv[e];
                    const int rowin = 4 * fr + m;
                    const bool deferred = (m == 0 && f0) || (m == 3 && f15);
                    if (!deferred) { u32x2 w; w.x = cvt_pk_bf16(o[0], o[1]); w.y = cvt_pk_bf16(o[2], o[3]); *(u32x2*)(ACT + (size_t)(kb * 64 + rowin) * 2816 + ch) = w; }
                    if ((f0 && m < 2) || (f15 && m >= 2)) { const int q = f0 ? m : m;
                        u32x2 wa, wv; wa.x = cvt_pk_bf16(ua[0], ua[1]); wa.y = cvt_pk_bf16(ua[2], ua[3]); wv.x = cvt_pk_bf16(uv[0], uv[1]); wv.y = cvt_pk_bf16(uv[2], uv[3]);
                        bf16_t* ub = UB + (size_t)((kb * 4 + q) * 2) * 2816 + ch; *(u32x2*)ub = wa; *(u32x2*)(ub + 2816) = wv; }
                }
            }
        }
    }
};
template <class Epi, class Sched, bool ALIGN_EPI = false, bool SP2 = false>
__device__ __forceinline__ void gemm_phase(PG8_LAS unsigned char* lds, const Gemm g, const Sched& S, const Epi& E, int tid_in) {
    int tid_ = tid_in; asm volatile("" : "+v"(tid_)); const int tid = tid_, wid = __builtin_amdgcn_readfirstlane(tid >> 6), lane = tid & 63, wr = wid >> 2, wc = wid & 3, fr = lane & 15, fq = lane >> 4;
    const int K = g.K, nt = K / BK;
    unsigned voffA[2], voffB[2];
#pragma unroll
    for (int i = 0; i < 2; ++i) { int R, C; stage_rc(tid * 16 + i * 8192, R, C); const int Rb = Epi::PERM ? ((R & ~31) + perm32(R & 31)) : R;
        const int Ra = Epi::APERM ? ((R & ~63) + 4 * (R & 15) + ((R & 63) >> 4)) : R;
        voffA[i] = (unsigned)(Ra * K + C) * 2u; voffB[i] = (unsigned)(Rb * K + C) * 2u; }
    const size_t kstep = (size_t)(BK * 2);
    const size_t hstep = (size_t)HALF * K * 2;
    const size_t tstep = 2 * hstep;
    const unsigned ldsw = (unsigned)wid * 1024u;
    const int aoff = lds_byte(wr * 64 + fr, fq * 8), boff = lds_byte(wc * 32 + fr, fq * 8);
#define PG8_SA(b, h) (((b) * 2 + (h)) * HTB)
#define PG8_SB(b, h) ((4 + (b) * 2 + (h)) * HTB)
#define PG8_STAGE(bufoff, gbase, voff) do { _Pragma("unroll") for (int _i = 0; _i < 2; ++_i) \
        __builtin_amdgcn_global_load_lds((const unsigned*)((const char*)(gbase) + (voff)[_i]), (PG8_LAS unsigned*)(lds + (bufoff) + ldsw + _i * 8192), 16, 0, 0); } while (0)
#define PG8_LDA(dst, b, h) do { _Pragma("unroll") for (int m = 0; m < 4; ++m) _Pragma("unroll") for (int k = 0; k < 2; ++k) dst[m][k] = *(const PG8_LAS bf16x8*)(lds + PG8_SA(b, h) + aoff + m * 2048 + k * 1024); } while (0)
#define PG8_LDB(dst, b, h) do { _Pragma("unroll") for (int n = 0; n < 2; ++n) _Pragma("unroll") for (int k = 0; k < 2; ++k) dst[n][k] = *(const PG8_LAS bf16x8*)(lds + PG8_SB(b, h) + boff + n * 2048 + k * 1024); } while (0)
#define PG8_MMA(ai, bj, At, Bt) do { __builtin_amdgcn_s_setprio(1); _Pragma("unroll") for (int m = 0; m < 4; ++m) _Pragma("unroll") for (int n = 0; n < 2; ++n) _Pragma("unroll") for (int k = 0; k < 2; ++k) \
        acc[ai][bj][m][n] = __builtin_amdgcn_mfma_f32_16x16x32_bf16(Bt[n][k], At[m][k], acc[ai][bj][m][n], 0, 0, 0); __builtin_amdgcn_s_setprio(0); } while (0)
#define PG8_WAIT_V(n) asm volatile("s_waitcnt vmcnt(" #n ")" ::: "memory")
#define PG8_WAIT_L(n) asm volatile("s_waitcnt lgkmcnt(" #n ")" ::: "memory")
#define PG8_BAR __builtin_amdgcn_s_barrier()
#define PG8_SCHED __builtin_amdgcn_sched_barrier(0)
    Unit cur, nxt; int ui = 0;
    if (!S.next(0, cur)) return;
    f32x4 acc[2][2][4][2];
#pragma unroll
    for (int a = 0; a < 2; ++a)
#pragma unroll
        for (int b = 0; b < 2; ++b)
#pragma unroll
            for (int m = 0; m < 4; ++m)
#pragma unroll
                for (int n = 0; n < 2; ++n) acc[a][b][m][n] = (f32x4){0.f, 0.f, 0.f, 0.f};
    bf16x8 At[4][2], B0[2][2], B1[2][2];
    const char* cA = (const char*)g.A + (size_t)cur.pm * tstep; const char* cB = (const char*)g.Bt + (size_t)cur.pn * tstep;
    S.a_ready(cur);
    if constexpr (SP2) {
        PG8_STAGE(PG8_SB(0, 0), cB, voffB); PG8_STAGE(PG8_SB(0, 1), cB + hstep, voffB); PG8_STAGE(PG8_SA(0, 0), cA, voffA); PG8_STAGE(PG8_SA(0, 1), cA + hstep, voffA);
        if (wr == 1) PG8_BAR;
        PG8_WAIT_V(2); PG8_BAR;
        PG8_STAGE(PG8_SB(1, 0), cB + kstep, voffB); PG8_STAGE(PG8_SA(1, 0), cA + kstep, voffA); PG8_STAGE(PG8_SB(1, 1), cB + hstep + kstep, voffB);
        PG8_WAIT_V(6); PG8_BAR;
    } else {
        PG8_STAGE(PG8_SB(0, 0), cB, voffB); PG8_STAGE(PG8_SA(0, 0), cA, voffA); PG8_STAGE(PG8_SB(0, 1), cB + hstep, voffB); PG8_STAGE(PG8_SA(0, 1), cA + hstep, voffA);
        if (wr == 1) PG8_BAR;
        PG8_WAIT_V(4); PG8_BAR;
        PG8_STAGE(PG8_SB(1, 0), cB + kstep, voffB); PG8_STAGE(PG8_SA(1, 0), cA + kstep, voffA); PG8_STAGE(PG8_SB(1, 1), cB + hstep + kstep, voffB);
        PG8_WAIT_V(6); PG8_BAR;
    }
    for (;;) {
        const bool has_next = S.next(ui + 1, nxt);
        const char* nA = has_next ? (const char*)g.A + (size_t)nxt.pm * tstep : cA; const char* nB = has_next ? (const char*)g.Bt + (size_t)nxt.pn * tstep : cB;
        for (int t = 0; t < nt; t += 2) {
            const bool last = (t == nt - 2);
            const char* a1 = cA + (size_t)(t + 1) * kstep;
            const char* a2 = last ? nA : cA + (size_t)(t + 2) * kstep; const char* b2 = last ? nB : cB + (size_t)(t + 2) * kstep;
            const char* a3 = a2 + kstep; const char* b3 = b2 + kstep;
            if (last && has_next) S.a_ready(nxt);
            if constexpr (SP2) {
            PG8_LDB(B0, 0, 0); PG8_LDB(B1, 0, 1); PG8_SCHED; PG8_LDA(At, 0, 0); PG8_STAGE(PG8_SA(1, 1), a1 + hstep, voffA);
            PG8_WAIT_V(8); PG8_WAIT_L(0); PG8_BAR; PG8_MMA(0, 0, At, B0); PG8_MMA(0, 1, At, B1); PG8_BAR; PG8_SCHED;
            PG8_LDA(At, 0, 1); PG8_STAGE(PG8_SB(0, 0), b2, voffB); PG8_STAGE(PG8_SB(0, 1), b2 + hstep, voffB); PG8_STAGE(PG8_SA(0, 0), a2, voffA);
            PG8_WAIT_V(8); PG8_WAIT_L(0); PG8_BAR; PG8_MMA(1, 0, At, B0); PG8_MMA(1, 1, At, B1); PG8_BAR; PG8_SCHED;
            PG8_LDB(B0, 1, 0); PG8_LDB(B1, 1, 1); PG8_SCHED; PG8_LDA(At, 1, 0); PG8_STAGE(PG8_SA(0, 1), a2 + hstep, voffA);
            PG8_WAIT_V(8); PG8_WAIT_L(0); PG8_BAR; PG8_MMA(0, 0, At, B0); PG8_MMA(0, 1, At, B1); PG8_BAR; PG8_SCHED;
            PG8_LDA(At, 1, 1); PG8_STAGE(PG8_SB(1, 0), b3, voffB); PG8_STAGE(PG8_SB(1, 1), b3 + hstep, voffB); PG8_STAGE(PG8_SA(1, 0), a3, voffA);
            PG8_WAIT_V(8); PG8_WAIT_L(0); PG8_BAR; PG8_MMA(1, 0, At, B0); PG8_MMA(1, 1, At, B1); PG8_BAR; PG8_SCHED;
            } else {
            PG8_LDB(B0, 0, 0); PG8_SCHED; PG8_LDA(At, 0, 0); PG8_STAGE(PG8_SA(1, 1), a1 + hstep, voffA);
            PG8_WAIT_L(8); PG8_BAR; PG8_WAIT_L(0); PG8_MMA(0, 0, At, B0); PG8_BAR; PG8_SCHED;
            PG8_LDB(B1, 0, 1); PG8_STAGE(PG8_SB(0, 0), b2, voffB);
            PG8_BAR; PG8_WAIT_L(0); PG8_MMA(0, 1, At, B1); PG8_BAR;
            PG8_LDA(At, 0, 1); PG8_STAGE(PG8_SA(0, 0), a2, voffA);
            PG8_BAR; PG8_WAIT_L(0); PG8_MMA(1, 0, At, B0); PG8_BAR; PG8_SCHED;
            PG8_STAGE(PG8_SB(0, 1), b2 + hstep, voffB);
            PG8_WAIT_V(6); PG8_BAR; PG8_MMA(1, 1, At, B1); PG8_BAR;
            PG8_LDB(B0, 1, 0); PG8_SCHED; PG8_LDA(At, 1, 0); PG8_STAGE(PG8_SA(0, 1), a2 + hstep, voffA);
            PG8_WAIT_L(8); PG8_BAR; PG8_WAIT_L(0); PG8_MMA(0, 0, At, B0); PG8_BAR; PG8_SCHED;
            PG8_LDB(B1, 1, 1); PG8_STAGE(PG8_SB(1, 0), b3, voffB);
            PG8_BAR; PG8_WAIT_L(0); PG8_MMA(0, 1, At, B1); PG8_BAR;
            PG8_LDA(At, 1, 1); PG8_STAGE(PG8_SA(1, 0), a3, voffA);
            PG8_BAR; PG8_WAIT_L(0); PG8_MMA(1, 0, At, B0); PG8_BAR; PG8_SCHED;
            PG8_STAGE(PG8_SB(1, 1), b3 + hstep, voffB);
            PG8_WAIT_V(6); PG8_BAR; PG8_MMA(1, 1, At, B1); PG8_BAR;
            }
        }
        if constexpr (ALIGN_EPI) { if (wr == 0) PG8_BAR; }
        if constexpr (!Epi::AFTER_DRAIN) { E(acc, cur, wr, wc, fr, fq); S.done(cur); }
        if (!has_next) break;
#pragma unroll
        for (int a = 0; a < 2; ++a)
#pragma unroll
            for (int b = 0; b < 2; ++b)
#pragma unroll
                for (int m = 0; m < 4; ++m)
#pragma unroll
                    for (int n = 0; n < 2; ++n) acc[a][b][m][n] = (f32x4){0.f, 0.f, 0.f, 0.f};
        cur = nxt; cA = nA; cB = nB; ++ui;
        if constexpr (ALIGN_EPI) { if (wr == 1) PG8_BAR; }
    }
    PG8_WAIT_V(0);
    if constexpr (!ALIGN_EPI) { if (wr == 0) PG8_BAR; }
    PG8_BAR;
    if constexpr (Epi::AFTER_DRAIN) { E.fused(acc, cur, wr, wc, fr, fq, lds, wid, lane); S.done(cur); }
#undef PG8_SA
#undef PG8_SB
#undef PG8_STAGE
#undef PG8_LDA
#undef PG8_LDB
#undef PG8_MMA
#undef PG8_WAIT_V
#undef PG8_WAIT_L
#undef PG8_BAR
#undef PG8_SCHED
}
}
#define DI __device__ __forceinline__
#define LAS __attribute__((address_space(3)))
typedef unsigned short bf16;
typedef unsigned v4u __attribute__((ext_vector_type(4)));
typedef unsigned v2u __attribute__((ext_vector_type(2)));
typedef float f32x4 __attribute__((ext_vector_type(4)));

constexpr int NB = 4, LSEQ = 8192, DM = 1024, LCTX = 256, NLAT = NB * LSEQ, NCTX = NB * LCTX, MTOT = NLAT + NCTX;
constexpr int INW = 3072, DFF = 2816, DFFH = 1408;
constexpr int CA_Q = 0, CA_K = 512, CA_V = 640, CB_QF = 768, CB_FF = 1024, CB_QB = 1280, CB_FB = 1536, CB_I = 1792, CB_G = 2048, CC_Q = 2304, CC_K = 2560, CC_V = 2816;
constexpr float EPS = 1e-6f;
constexpr size_t MiB = 1u << 20;
constexpr size_t WS_SMALL = 1 * MiB, WS_WIN = 2 * MiB, WS_WOUT = 14 * MiB, WS_WUP = 18 * MiB, WS_WDN = 40 * MiB, WS_XC = 52 * MiB, WS_H = 56 * MiB, WS_MIX = 122 * MiB,
                 WS_P = 188 * MiB, WS_ST = 386 * MiB, WS_U = 188 * MiB, WS_ACT = 370 * MiB, WS_END = 462 * MiB;
constexpr int SM_MOD = 0  , SM_TAC = 65536, SM_TAS = SM_TAC + 2048, SM_TDC = SM_TAS + 2048, SM_TDS = SM_TDC + 1024, SM_LOWER = SM_TDS + 1024  , SM_LAM = SM_LOWER + 1024;
constexpr int LDS_BYTES = 147456;

DI unsigned f2bf(float f) { unsigned u = __builtin_bit_cast(unsigned, f); return (u + 0x7fffu + ((u >> 16) & 1u)) >> 16; }
DI unsigned pk2(float lo, float hi) { return f2bf(lo) | (f2bf(hi) << 16); }
DI float bf2f(bf16 u) { return __builtin_bit_cast(float, ((unsigned)u) << 16); }
DI float shx_(int lane, float v, int m) { return __builtin_bit_cast(float, __builtin_amdgcn_ds_bpermute((lane ^ m) << 2, __builtin_bit_cast(int, v))); }
DI float wave_sum(int lane, float v) {
#pragma unroll
    for (int o = 1; o < 64; o <<= 1) v += shx_(lane, v, o);
    return v;
}
DI float wave_max(int lane, float v) {
#pragma unroll
    for (int o = 1; o < 64; o <<= 1) v = fmaxf(v, shx_(lane, v, o));
    return v;
}
DI float silu_f(float x) { return x / (1.f + __expf(-x)); }
DI float sigmoid_f(float x) { return 1.f / (1.f + __expf(-x)); }

struct Args { const float* in[23]; float* out; unsigned char* ws; };
struct Ctx {
    const float *x, *c, *ctx, *c_ctx, *w_mod, *b_mod, *n1g, *n2g, *w_in, *wqg, *wkg, *wsink, *hglow, *hgog, *dqg, *dkg, *dlam, *dog, *w_out, *w_up, *conv_w, *conv_b, *w_down;
    float* out; unsigned char* ws;
    float* SM; bf16 *Win_t, *Wout_t, *Wup_t, *Wdn_t, *H, *MIX, *P, *U, *ACT; float *XC, *ST;
    int lane, wave, tid, gw, NGW;
};


DI int fresh_lane() { int l_; asm volatile("v_mbcnt_lo_u32_b32 %0, -1, 0\n\tv_mbcnt_hi_u32_b32 %0, -1, %0" : "=v"(l_)); return l_; }
DI Ctx make_ctx(const Args& args, int wave_s) {
    Ctx C;
    C.x = args.in[0]; C.c = args.in[1]; C.ctx = args.in[2]; C.c_ctx = args.in[3]; C.w_mod = args.in[4]; C.b_mod = args.in[5]; C.n1g = args.in[6]; C.n2g = args.in[7];
    C.w_in = args.in[8]; C.wqg = args.in[9]; C.wkg = args.in[10]; C.wsink = args.in[11]; C.hglow = args.in[12]; C.hgog = args.in[13]; C.dqg = args.in[14]; C.dkg = args.in[15];
    C.dlam = args.in[16]; C.dog = args.in[17]; C.w_out = args.in[18]; C.w_up = args.in[19]; C.conv_w = args.in[20]; C.conv_b = args.in[21]; C.w_down = args.in[22];
    C.out = args.out; C.ws = args.ws;
    C.SM = (float*)(args.ws + WS_SMALL); C.Win_t = (bf16*)(args.ws + WS_WIN); C.Wout_t = (bf16*)(args.ws + WS_WOUT); C.Wup_t = (bf16*)(args.ws + WS_WUP); C.Wdn_t = (bf16*)(args.ws + WS_WDN);
    C.XC = (float*)(args.ws + WS_XC); C.H = (bf16*)(args.ws + WS_H); C.MIX = (bf16*)(args.ws + WS_MIX); C.P = (bf16*)(args.ws + WS_P); C.ST = (float*)(args.ws + WS_ST);
    C.U = (bf16*)(args.ws + WS_U); C.ACT = (bf16*)(args.ws + WS_ACT);
    C.lane = fresh_lane(); C.wave = wave_s; C.tid = wave_s * 64 + C.lane; C.gw = blockIdx.x * 8 + C.wave; C.NGW = gridDim.x * 8;
    return C;
}

DI void p0_transpose_item(const float* W, int N, int k0, int n0, bf16* dst, int dst_ld, LAS float* scr, int lane) {
    f32x4 v[8];
#pragma unroll
    for (int i = 0; i < 8; ++i) v[i] = __builtin_nontemporal_load((const f32x4*)(W + (size_t)(k0 + 8 * i + (lane >> 3)) * N + n0 + 4 * (lane & 7)));
#pragma unroll
    for (int i = 0; i < 8; ++i) { LAS float* q = scr + (8 * i + (lane >> 3)) * 33 + 4 * (lane & 7); q[0] = v[i].x; q[1] = v[i].y; q[2] = v[i].z; q[3] = v[i].w; }
    asm volatile("s_waitcnt lgkmcnt(0)" ::: "memory");
    const int c = lane & 7;
#pragma unroll
    for (int j = 0; j < 4; ++j) { const int n = (lane >> 3) + 8 * j; const LAS float* s = scr + (8 * c) * 33 + n;
        v4u o; o.x = pk2(s[0 * 33], s[1 * 33]); o.y = pk2(s[2 * 33], s[3 * 33]); o.z = pk2(s[4 * 33], s[5 * 33]); o.w = pk2(s[6 * 33], s[7 * 33]);
        *(v4u*)(dst + (size_t)n * dst_ld + 8 * c) = o; }
    asm volatile("s_waitcnt lgkmcnt(0)" ::: "memory");
}
DI int permup(int n) { const int a = n >= DFF ? 1 : 0; const int ch = n - a * DFF; return (ch >> 7) * 256 + a * 128 + (ch & 127); }

DI void p0_phase(const Args& A, int wave_s, LAS unsigned char* lds) {
    const Ctx C = make_ctx(A, wave_s);
    {
        LAS float* sv = (LAS float*)lds;
        LAS float* red = (LAS float*)(lds + 32768);
        for (int unit = blockIdx.x; unit < 192; unit += gridDim.x) {
            const int l = unit / 96, c0 = (unit % 96) * 64;
            __syncthreads();
            for (int e = C.tid; e < 5120; e += 512) { const int v = e >> 10, k = e & 1023; const float xv = v < 4 ? C.c[v * 1024 + k] : C.c_ctx[k]; sv[e] = silu_f(xv); }
            __syncthreads();
            const float* W = C.w_mod + (size_t)l * 1024 * 6144 + c0 + C.lane;
            float a0 = 0.f, a1 = 0.f, a2 = 0.f, a3 = 0.f, a4 = 0.f;
            const int kb = C.wave * 128;
#pragma unroll 16
            for (int k = 0; k < 128; ++k) { const float w = __builtin_nontemporal_load(W + (size_t)(kb + k) * 6144);
                a0 += sv[kb + k] * w; a1 += sv[1024 + kb + k] * w; a2 += sv[2048 + kb + k] * w; a3 += sv[3072 + kb + k] * w; a4 += sv[4096 + kb + k] * w; }
            red[(C.wave * 5 + 0) * 64 + C.lane] = a0; red[(C.wave * 5 + 1) * 64 + C.lane] = a1; red[(C.wave * 5 + 2) * 64 + C.lane] = a2;
            red[(C.wave * 5 + 3) * 64 + C.lane] = a3; red[(C.wave * 5 + 4) * 64 + C.lane] = a4;
            __syncthreads();
            if (C.tid < 320) { const int v = C.tid >> 6, cc = C.tid & 63; float s = 0.f;
#pragma unroll
                for (int w = 0; w < 8; ++w) s += red[(w * 5 + v) * 64 + cc];
                C.SM[SM_MOD + (l * 5 + v) * 6144 + c0 + cc] = s + C.b_mod[l * 6144 + c0 + cc]; }
        }
        __syncthreads();
    }
    if (blockIdx.x == gridDim.x - 1) {
        for (int e = C.tid; e < 2048; e += 512) { const int p = e >> 4, i = e & 15;
            const float inv = exp2f((float)(-(double)i / 16.0 * 13.287712379549449)); const float ang = (float)p * inv;
            const double ad = (double)ang * 0.15915494309189535; const double kk = __builtin_rint(ad); const float rev = (float)(ad - kk);
            C.SM[SM_TAC + e] = __builtin_amdgcn_cosf(rev); C.SM[SM_TAS + e] = __builtin_amdgcn_sinf(rev); }
        for (int e = C.tid; e < 1024; e += 512) { const int p = e >> 3, i = e & 7;
            const float inv = exp2f((float)(-(double)i / 8.0 * 13.287712379549449)); const float ang = (float)p * inv;
            const double ad = (double)ang * 0.15915494309189535; const double kk = __builtin_rint(ad); const float rev = (float)(ad - kk);
            C.SM[SM_TDC + e] = __builtin_amdgcn_cosf(rev); C.SM[SM_TDS + e] = __builtin_amdgcn_sinf(rev); }
        for (int e = C.tid; e < 512; e += 512) { C.SM[SM_LOWER + e] = 0.f; C.SM[SM_LOWER + 512 + e] = 1.f / (1.f + __expf(C.hglow[e] - C.hglow[512 + e])); }
        if (C.wave == 0) {
            for (int l = 0; l < 2; ++l) { const float* L = C.dlam + l * 128;
                float a = C.lane < 32 ? L[C.lane] * L[32 + C.lane] : 0.f, b = C.lane < 32 ? L[64 + C.lane] * L[96 + C.lane] : 0.f;
                a = wave_sum(C.lane, a); b = wave_sum(C.lane, b);
                const float lam_init = 0.8f - 0.6f * __expf(-0.3f * (float)l);
                if (C.lane == 0) C.SM[SM_LAM + l] = __expf(a) - __expf(b) + lam_init; }
        }
    }
}
DI void p0_transposes(const Args& A, int wave_s, LAS unsigned char* lds, int it_lo, int it_hi, int widx, int nworkers) {
    const Ctx C = make_ctx(A, wave_s);
    LAS float* scr = (LAS float*)(lds + 49152 + C.wave * 8704);
    constexpr int I_IN = 16 * 96, I_OUT = 16 * 32, I_UP = 16 * 176, I_DN = 44 * 32, I_L = I_IN + I_OUT + I_UP + I_DN;
    for (int it = it_lo + widx; it < it_hi; it += nworkers) {
        const int l = it / I_L; int r = it % I_L;
        if (r < I_IN) { const int kb = r / 96, nb = r % 96; p0_transpose_item(C.w_in + (size_t)l * 1024 * 3072, 3072, 64 * kb, 32 * nb, C.Win_t + (size_t)l * 3072 * 1024 + (size_t)(32 * nb) * 1024 + 64 * kb, 1024, scr, C.lane); continue; } r -= I_IN;
        if (r < I_OUT) { const int kb = r / 32, nb = r % 32; p0_transpose_item(C.w_out + (size_t)l * 1024 * 1024, 1024, 64 * kb, 32 * nb, C.Wout_t + (size_t)l * 1024 * 1024 + (size_t)(32 * nb) * 1024 + 64 * kb, 1024, scr, C.lane); continue; } r -= I_OUT;
        if (r < I_UP) { const int kb = r / 176, nb = r % 176; p0_transpose_item(C.w_up + (size_t)l * 1024 * 5632, 5632, 64 * kb, 32 * nb, C.Wup_t + (size_t)l * 5632 * 1024 + (size_t)permup(32 * nb) * 1024 + 64 * kb, 1024, scr, C.lane); continue; } r -= I_UP;
        { const int kb = r / 32, nb = r % 32; const int k0 = 64 * kb;
          p0_transpose_item(C.w_down + (size_t)l * 2816 * 1024, 1024, k0, 32 * nb, C.Wdn_t + (size_t)l * 2816 * 1024 + (size_t)(32 * nb) * DFF + k0, DFF, scr, C.lane); }
    }
}

DI void norm_phase(const Args& A, int wave_s, int l, int which, int rows) {
    const Ctx C = make_ctx(A, wave_s);
    const float* gn = (which == 1 ? C.n1g : C.n2g) + l * 1024;
    const bool from_in = (l == 0 && which == 1);
    f32x4 g[4];
#pragma unroll
    for (int j = 0; j < 4; ++j) g[j] = *(const f32x4*)(gn + 4 * (C.lane + 64 * j));
    for (int m0 = C.gw * 2; m0 < rows; m0 += C.NGW * 2) {
        f32x4 xv[2][4];
        const float* modp[2];
#pragma unroll
        for (int rr = 0; rr < 2; ++rr) {
            const int m = m0 + rr; const float* xr; int v;
            if (m < NLAT) { xr = (from_in ? C.x : C.out) + (size_t)m * 1024; v = m >> 13; }
            else { xr = (from_in ? C.ctx : C.XC) + (size_t)(m - NLAT) * 1024; v = 4; }
            modp[rr] = C.SM + SM_MOD + (l * 5 + v) * 6144 + (which == 1 ? 0 : 3072);
#pragma unroll
            for (int j = 0; j < 4; ++j) xv[rr][j] = ((const f32x4*)xr)[C.lane + 64 * j];
        }
#pragma unroll
        for (int rr = 0; rr < 2; ++rr) {
            const int m = m0 + rr;
            f32x4 sh[4], sc[4];
#pragma unroll
            for (int j = 0; j < 4; ++j) { const int col = 4 * (C.lane + 64 * j); sh[j] = *(const f32x4*)(modp[rr] + col); sc[j] = *(const f32x4*)(modp[rr] + 1024 + col); }
            float ss = 0.f;
#pragma unroll
            for (int j = 0; j < 4; ++j) ss += (xv[rr][j].x * xv[rr][j].x + xv[rr][j].y * xv[rr][j].y) + (xv[rr][j].z * xv[rr][j].z + xv[rr][j].w * xv[rr][j].w);
            ss = wave_sum(C.lane, ss);
            const float rs = rsqrtf(ss * (1.f / 1024.f) + EPS);
#pragma unroll
            for (int j = 0; j < 4; ++j) { const int col = 4 * (C.lane + 64 * j);
                const f32x4 y = xv[rr][j] * rs * g[j] * (sc[j] + 1.f) + sh[j];
                v2u o; o.x = pk2(y.x, y.y); o.y = pk2(y.z, y.w);
                *(v2u*)(C.H + (size_t)m * 1024 + col) = o; }
        }
    }
}

DI void unpack8(const v4u w, float (&x)[8]) {
#pragma unroll
    for (int q = 0; q < 4; ++q) { x[2 * q] = __builtin_bit_cast(float, w[q] << 16); x[2 * q + 1] = __builtin_bit_cast(float, w[q] & 0xffff0000u); }
}
DI void prep_phase(const Args& A, int wave_s, int l) {
    const Ctx C = make_ctx(A, wave_s);
    const int L = C.lane, jA = L & 7, jD = L & 3;
    float gqA[8], gkA[8], gD[8];
#pragma unroll
    for (int e = 0; e < 8; ++e) { gqA[e] = C.wqg[l * 64 + 8 * jA + e] * (0.125f * 1.4426950408889634f); gkA[e] = C.wkg[l * 64 + 8 * jA + e];
        gD[e] = (L < 32) ? C.dqg[l * 32 + 8 * jD + e] * (0.17677669529663687f * 1.4426950408889634f) : C.dkg[l * 32 + 8 * jD + e]; }
    const float* TAC = C.SM + SM_TAC; const float* TAS = C.SM + SM_TAS; const float* TDC = C.SM + SM_TDC; const float* TDS = C.SM + SM_TDS;
    for (int m = C.gw; m < MTOT; m += C.NGW) {
        bf16* pr = C.P + (size_t)m * INW;
        const bool latent = m < NLAT; const int t = m & 8191, rpos = t >> 6, cpos = t & 63;
        const v4u wq = *(const v4u*)(pr + 8 * L), wk = (L < 16) ? *(const v4u*)(pr + 512 + 8 * L) : (v4u){0u, 0u, 0u, 0u}, wd = *(const v4u*)(pr + CC_Q + 8 * L);
        float cA[8], sA[8], cD[8], sD[8];
        if (latent) { const int posA = (jA < 4) ? rpos : cpos, iA = 8 * (jA & 1); const int posD = (jD < 2) ? rpos : cpos;
#pragma unroll
            for (int e = 0; e < 8; ++e) { cA[e] = TAC[posA * 16 + iA + e]; sA[e] = TAS[posA * 16 + iA + e]; cD[e] = TDC[posD * 8 + e]; sD[e] = TDS[posD * 8 + e]; }
        } else {
#pragma unroll
            for (int e = 0; e < 8; ++e) { cA[e] = 1.f; sA[e] = 0.f; cD[e] = 1.f; sD[e] = 0.f; }
        }
#pragma unroll
        for (int part = 0; part < 2; ++part) {
            float x[8]; unpack8(part ? wk : wq, x);
            float ss = 0.f;
#pragma unroll
            for (int e = 0; e < 8; ++e) ss += x[e] * x[e];
            ss += shx_(L, ss, 1); ss += shx_(L, ss, 2); ss += shx_(L, ss, 4);
            const float rs = rsqrtf(ss * (1.f / 64.f) + EPS);
            float y[8], y2[8];
#pragma unroll
            for (int e = 0; e < 8; ++e) y[e] = x[e] * rs * (part ? gkA[e] : gqA[e]);
#pragma unroll
            for (int e = 0; e < 8; ++e) y2[e] = shx_(L, y[e], 2);
            unsigned o[4];
#pragma unroll
            for (int q = 0; q < 4; ++q) { float r0, r1;
                { const int e = 2 * q; r0 = (jA & 2) ? (y2[e] * sA[e] + y[e] * cA[e]) : (y[e] * cA[e] - y2[e] * sA[e]); }
                { const int e = 2 * q + 1; r1 = (jA & 2) ? (y2[e] * sA[e] + y[e] * cA[e]) : (y[e] * cA[e] - y2[e] * sA[e]); }
                o[q] = pk2(r0, r1); }
            const v4u ov = {o[0], o[1], o[2], o[3]};
            if (part == 0) *(v4u*)(pr + 8 * L) = ov; else if (L < 16) *(v4u*)(pr + 512 + 8 * L) = ov;
        }
        {
            float x[8]; unpack8(wd, x);
            float ss = 0.f;
#pragma unroll
            for (int e = 0; e < 8; ++e) ss += x[e] * x[e];
            ss += shx_(L, ss, 1); ss += shx_(L, ss, 2);
            const float rs = rsqrtf(ss * (1.f / 32.f) + EPS);
            float y[8], y2[8];
#pragma unroll
            for (int e = 0; e < 8; ++e) y[e] = x[e] * rs * gD[e];
#pragma unroll
            for (int e = 0; e < 8; ++e) y2[e] = shx_(L, y[e], 1);
            unsigned o[4];
#pragma unroll
            for (int q = 0; q < 4; ++q) { float r0, r1;
                { const int e = 2 * q; r0 = (jD & 1) ? (y2[e] * sD[e] + y[e] * cD[e]) : (y[e] * cD[e] - y2[e] * sD[e]); }
                { const int e = 2 * q + 1; r1 = (jD & 1) ? (y2[e] * sD[e] + y[e] * cD[e]) : (y[e] * cD[e] - y2[e] * sD[e]); }
                o[q] = pk2(r0, r1); }
            *(v4u*)(pr + CC_Q + 8 * L) = (v4u){o[0], o[1], o[2], o[3]};
        }
    }
}

DI void hgrn_naive(const Args& A, int wave_s, int l, bool need_ctx) {
    const Ctx C = make_ctx(A, wave_s);
    const float og = C.hgog[l * 64 + C.lane];
    for (int task = C.gw; task < 16; task += C.NGW) {
        const int b = task >> 2, h = task & 3;
        for (int dir = 0; dir < 2; ++dir) {
            const float lbv = C.SM[SM_LOWER + (l * 2 + dir) * 256 + h * 64 + C.lane];
            float S[64];
#pragma unroll
            for (int k = 0; k < 64; ++k) S[k] = 0.f;
            const int qcol = (dir ? CB_QB : CB_QF) + h * 64 + C.lane, fcol = (dir ? CB_FB : CB_FF) + h * 64 + C.lane;
            for (int step = 0; step < LCTX + LSEQ; ++step) {
                int r;
                if (step < LCTX) { const int tc = dir ? (LCTX - 1 - step) : step; r = NLAT + b * LCTX + tc; }
                else { const int t0 = step - LCTX; const int t = dir ? (LSEQ - 1 - t0) : t0; r = b * LSEQ + t; }
                const bf16* pr = C.P + (size_t)r * INW;
                const float qv = bf2f(pr[qcol]), pf = bf2f(pr[fcol]), iv = bf2f(pr[CB_I + h * 64 + C.lane]);
                const float f = lbv + (1.f - lbv) * sigmoid_f(pf), kk = 1.f - f;
                float o = 0.f;
#pragma unroll
                for (int k = 0; k < 64; ++k) {
                    const float fk = __builtin_bit_cast(float, __builtin_amdgcn_readlane(__builtin_bit_cast(int, f), k));
                    const float kx = __builtin_bit_cast(float, __builtin_amdgcn_readlane(__builtin_bit_cast(int, kk), k));
                    const float qk = __builtin_bit_cast(float, __builtin_amdgcn_readlane(__builtin_bit_cast(int, qv), k));
                    S[k] = fk * S[k] + kx * iv; o += S[k] * qk;
                }
                float* op = C.ST + (size_t)r * 256 + h * 64 + C.lane;
                if (dir == 0) { *op = o; }
                else if (r < NLAT || need_ctx) {
                    const float tot = *op + o; const float ss = wave_sum(C.lane, tot * tot);
                    const float g = bf2f(pr[CB_G + h * 64 + C.lane]);
                    const float y = tot * rsqrtf(ss * (1.f / 64.f) + EPS) * og * silu_f(g);
                    C.MIX[(size_t)r * 1024 + 512 + h * 64 + C.lane] = (bf16)f2bf(y);
                }
            }
        }
    }
}

DI void win_naive(const Args& A, int wave_s, int l, bool need_ctx) {
    const Ctx C = make_ctx(A, wave_s);
    const float Mb = 8.f * 1.4426950408889634f * wave_max(C.lane, fabsf(C.wqg[l * 64 + C.lane])) * wave_max(C.lane, fabsf(C.wkg[l * 64 + C.lane]));
    const int ntask = (need_ctx ? MTOT : NLAT) * 8;
    for (int task = C.gw; task < ntask; task += C.NGW) {
        const int m = task >> 3, h = task & 7, kv = h >> 2;
        const float qx = bf2f(C.P[(size_t)m * INW + CA_Q + h * 64 + C.lane]);
        float lsum = 0.f, acc = 0.f;
        int b;
        if (m < NLAT) {
            b = m >> 13; const int t = m & 8191; const int lo = t - 128 < 0 ? 0 : t - 128, hi = t + 128 > LSEQ - 1 ? LSEQ - 1 : t + 128;
            for (int kt = lo; kt <= hi; ++kt) { const bf16* kr = C.P + (size_t)(b * LSEQ + kt) * INW;
                const float s = wave_sum(C.lane, qx * bf2f(kr[CA_K + kv * 64 + C.lane])); const float e = __builtin_amdgcn_exp2f(s - Mb);
                lsum += e; acc += e * bf2f(kr[CA_V + kv * 64 + C.lane]); }
        } else b = (m - NLAT) >> 8;
        for (int kc = 0; kc < LCTX; ++kc) { const bf16* kr = C.P + (size_t)(NLAT + b * LCTX + kc) * INW;
            const float s = wave_sum(C.lane, qx * bf2f(kr[CA_K + kv * 64 + C.lane])); const float e = __builtin_amdgcn_exp2f(s - Mb);
            lsum += e; acc += e * bf2f(kr[CA_V + kv * 64 + C.lane]); }
        const float o = acc / (lsum + __builtin_amdgcn_exp2f(C.wsink[l * 8 + h] * 1.4426950408889634f - Mb));
        C.MIX[(size_t)m * 1024 + h * 64 + C.lane] = (bf16)f2bf(o);
    }
}

DI void diff_naive(const Args& A, int wave_s, int l, bool need_ctx) {
    const Ctx C = make_ctx(A, wave_s);
    const float Mb = 5.656854249f * wave_max(C.lane, fabsf(C.dqg[l * 32 + (C.lane & 31)])) * wave_max(C.lane, fabsf(C.dkg[l * 32 + (C.lane & 31)]));
    const float lam = C.SM[SM_LAM + l]; const float lam_init = 0.8f - 0.6f * __expf(-0.3f * (float)l);
    const float og = C.dog[l * 64 + C.lane];
    const int ntask = (need_ctx ? MTOT : NLAT) * 4;
    for (int task = C.gw; task < ntask; task += C.NGW) {
        const int m = task >> 2, h = task & 3;
        const float qx = bf2f(C.P[(size_t)m * INW + CC_Q + h * 64 + C.lane]);
        float l0 = 0.f, l1 = 0.f, a0 = 0.f, a1 = 0.f;
        const bool latent = m < NLAT; const int b = latent ? (m >> 13) : ((m - NLAT) >> 8);
        const int nk = latent ? LSEQ + LCTX : LCTX;
        for (int j = 0; j < nk; ++j) {
            const int r = latent ? (j < LSEQ ? b * LSEQ + j : NLAT + b * LCTX + (j - LSEQ)) : NLAT + b * LCTX + j;
            const bf16* kr = C.P + (size_t)r * INW;
            float pr = qx * bf2f(kr[CC_K + h * 64 + C.lane]);
#pragma unroll
            for (int o = 1; o < 32; o <<= 1) pr += shx_(C.lane, pr, o);
            const float po = shx_(C.lane, pr, 32);
            const float s0 = (C.lane < 32 ? pr : po) * 0.17677669529663687f, s1 = (C.lane < 32 ? po : pr) * 0.17677669529663687f;
            const float e0 = __expf(s0 - Mb), e1 = __expf(s1 - Mb);
            const float vv = bf2f(kr[CC_V + h * 64 + C.lane]);
            l0 += e0; l1 += e1; a0 += e0 * vv; a1 += e1 * vv;
        }
        const float o = a0 / l0 - lam * (a1 / l1);
        const float ss = wave_sum(C.lane, o * o);
        const float y = o * rsqrtf(ss * (1.f / 64.f) + EPS) * og * (1.f - lam_init);
        C.MIX[(size_t)m * 1024 + 768 + h * 64 + C.lane] = (bf16)f2bf(y);
    }
}


typedef short bf16x8 __attribute__((ext_vector_type(8)));
typedef short s16x4 __attribute__((ext_vector_type(4)));
typedef float f32x16 __attribute__((ext_vector_type(16)));
typedef __bf16 bfv2 __attribute__((ext_vector_type(2)));
typedef float fv2 __attribute__((ext_vector_type(2)));
DI unsigned pkbf(float a, float b) { fv2 v = {a, b}; return __builtin_bit_cast(unsigned, __builtin_convertvector(v, bfv2)); }
#define MFMA32(a, b, c) __builtin_amdgcn_mfma_f32_32x32x16_bf16((a), (b), (c), 0, 0, 0)
#define PACK8(x, s) __builtin_bit_cast(bf16x8, (v4u){pkbf((x)[8 * (s)], (x)[8 * (s) + 1]), pkbf((x)[8 * (s) + 2], (x)[8 * (s) + 3]), pkbf((x)[8 * (s) + 4], (x)[8 * (s) + 5]), pkbf((x)[8 * (s) + 6], (x)[8 * (s) + 7])})
DI bf16x8 tr_pair(LAS unsigned char* p) {
    const s16x4 lo = __builtin_amdgcn_ds_read_tr16_b64_v4i16((LAS s16x4*)p), hi = __builtin_amdgcn_ds_read_tr16_b64_v4i16((LAS s16x4*)(p + 8 * 144));
    return __builtin_shufflevector(lo, hi, 0, 1, 2, 3, 4, 5, 6, 7);
}
constexpr int KV_PITCH = 144, KV_IMG = 64 * KV_PITCH;
constexpr int VP = 192;
DI bf16x8 tr_pairV(LAS unsigned char* p) {
    const s16x4 lo = __builtin_amdgcn_ds_read_tr16_b64_v4i16((LAS s16x4*)p), hi = __builtin_amdgcn_ds_read_tr16_b64_v4i16((LAS s16x4*)(p + 8 * VP));
    return __builtin_shufflevector(lo, hi, 0, 1, 2, 3, 4, 5, 6, 7);
}

constexpr int DT_ROWS = 128, DT_IMG = DT_ROWS * KV_PITCH;
DI void diff_mfma_phase(const Args& A, int wave_s, int l, bool need_ctx, LAS unsigned char* lds) {
    const Ctx C = make_ctx(A, wave_s);
    const int lane = C.lane, wave = C.wave, r = lane & 31, h = lane >> 5;
    const float Mb2 = 5.656854249f * 1.4426950408889634f * wave_max(C.lane, fabsf(C.dqg[l * 32 + (lane & 31)])) * wave_max(C.lane, fabsf(C.dkg[l * 32 + (lane & 31)]));
    const float lam = C.SM[SM_LAM + l]; const float lam_init = 0.8f - 0.6f * __expf(-0.3f * (float)l);
    const int nunits = 512 + (need_ctx ? 16 : 0);
    const int srow = C.tid >> 3, sch = C.tid & 7;
    const unsigned sgoff = (unsigned)(srow * INW + sch * 8) * 2u;
    const int q4 = (lane & 15) >> 2, p4 = lane & 3, grp = (lane >> 4) & 1;
    const int voff = (4 * h + q4) * VP + (16 * grp + 4 * p4) * 2;
    constexpr int DV_IMG = DT_ROWS * VP, VOFF0 = 2 * DT_IMG;
    f32x16 negM;
#pragma unroll
    for (int i = 0; i < 16; ++i) negM[i] = 0.f;
    (void)Mb2;
    for (int u = blockIdx.x; u < nunits; u += gridDim.x) {
        int b, hd, qrow0, ntiles;
        if (u < 512) { b = u >> 7; hd = (u >> 5) & 3; qrow0 = b * LSEQ + (u & 31) * 256; ntiles = 66; }
        else { const int uu = u - 512; b = uu >> 2; hd = uu & 3; qrow0 = NLAT + b * LCTX; ntiles = 2; }
        const int kbase0 = (u < 512) ? b * LSEQ : NLAT + b * LCTX, kbase1 = NLAT + b * LCTX - 64 * DT_ROWS;
        const bf16* qp = C.P + (size_t)qrow0 * INW + CC_Q + hd * 64 + (unsigned)((wave * 32 + r) * INW);
        bf16x8 Qf[2][2];
#pragma unroll
        for (int c = 0; c < 2; ++c)
#pragma unroll
            for (int s = 0; s < 2; ++s) Qf[c][s] = *(const bf16x8*)(qp + c * 32 + s * 16 + h * 8);
        f32x16 O[2][2];
#pragma unroll
        for (int c = 0; c < 2; ++c)
#pragma unroll
            for (int mt = 0; mt < 2; ++mt)
#pragma unroll
                for (int i = 0; i < 16; ++i) O[c][mt][i] = 0.f;
        float ls0 = 0.f, ls1 = 0.f;
        bf16x8 Pp0 = {0, 0, 0, 0, 0, 0, 0, 0}, Pp1 = {0, 0, 0, 0, 0, 0, 0, 0};
        bf16x8 Vs[4];
#pragma unroll
        for (int b_ = 0; b_ < 4; ++b_) Vs[b_] = (bf16x8){0, 0, 0, 0, 0, 0, 0, 0};
        v4u kreg[2], vreg[2];
        { const char* kb_ = (const char*)(C.P + (size_t)kbase0 * INW + CC_K + hd * 64); const char* vb_ = (const char*)(C.P + (size_t)kbase0 * INW + CC_V + hd * 64);
          kreg[0] = *(const v4u*)(kb_ + sgoff); vreg[0] = *(const v4u*)(vb_ + sgoff);
          kreg[1] = *(const v4u*)(kb_ + (size_t)64 * INW * 2 + sgoff); vreg[1] = *(const v4u*)(vb_ + (size_t)64 * INW * 2 + sgoff); }
        __syncthreads();
        *(LAS v4u*)(lds + srow * KV_PITCH + sch * 16) = kreg[0]; *(LAS v4u*)(lds + (srow + 64) * KV_PITCH + sch * 16) = kreg[1];
        *(LAS v4u*)(lds + VOFF0 + srow * VP + sch * 16) = vreg[0]; *(LAS v4u*)(lds + VOFF0 + (srow + 64) * VP + sch * 16) = vreg[1];
        __syncthreads();
        for (int it = 0; it < ntiles; ++it) {
            const int cur = it & 1;
            if (it + 1 < ntiles) { const int kr0 = (it + 1 < 64 ? kbase0 : kbase1) + (it + 1) * DT_ROWS;
                const char* kb_ = (const char*)(C.P + (size_t)kr0 * INW + CC_K + hd * 64);
                kreg[0] = *(const v4u*)(kb_ + sgoff); kreg[1] = *(const v4u*)(kb_ + (size_t)64 * INW * 2 + sgoff); }
            LAS unsigned char* Kb = lds + cur * DT_IMG; LAS unsigned char* Vb = lds + VOFF0 + cur * DV_IMG;
            LAS unsigned char* kl = Kb + r * KV_PITCH + h * 16;
            f32x16 Sc;
            { const bf16x8 kA0 = *(LAS bf16x8*)(kl), kA1 = *(LAS bf16x8*)(kl + 32); Sc = MFMA32(kA0, Qf[0][0], negM); Sc = MFMA32(kA1, Qf[0][1], Sc); }
#pragma unroll
            for (int g = 0; g < 8; ++g) {
                const int c = g & 1, sub = g >> 1;
                bf16x8 kB0, kB1; f32x16 Sn;
                if (g < 7) { LAS unsigned char* kp = kl + (32 * ((g + 1) >> 1)) * KV_PITCH + (c ^ 1) * 64; kB0 = *(LAS bf16x8*)(kp); kB1 = *(LAS bf16x8*)(kp + 32); }
                if (c == 0) { O[1][0] = MFMA32(Vs[0], Pp0, O[1][0]); O[1][1] = MFMA32(Vs[2], Pp0, O[1][1]); O[1][0] = MFMA32(Vs[1], Pp1, O[1][0]); O[1][1] = MFMA32(Vs[3], Pp1, O[1][1]); }
                else        { O[0][0] = MFMA32(Vs[0], Pp0, O[0][0]); O[0][1] = MFMA32(Vs[2], Pp0, O[0][1]); O[0][0] = MFMA32(Vs[1], Pp1, O[0][0]); O[0][1] = MFMA32(Vs[3], Pp1, O[0][1]); }
                float t = 0.f;
#pragma unroll
                for (int i = 0; i < 8; ++i) { Sc[i] = __builtin_amdgcn_exp2f(Sc[i]); t += Sc[i]; }
                const bf16x8 Pn0 = PACK8(Sc, 0);
                __builtin_amdgcn_sched_barrier(0);
                if (g < 7) { Sn = MFMA32(kB0, Qf[c ^ 1][0], negM); Sn = MFMA32(kB1, Qf[c ^ 1][1], Sn); }
                __builtin_amdgcn_sched_barrier(0);
                if (c == 0) { LAS unsigned char* vp = Vb + (32 * sub) * VP + voff; Vs[0] = tr_pairV(vp); Vs[1] = tr_pairV(vp + 16 * VP); Vs[2] = tr_pairV(vp + 64); Vs[3] = tr_pairV(vp + 16 * VP + 64); }
#pragma unroll
                for (int i = 8; i < 16; ++i) { Sc[i] = __builtin_amdgcn_exp2f(Sc[i]); t += Sc[i]; }
                if (c == 0) ls0 += t; else ls1 += t;
                Pp0 = Pn0; Pp1 = PACK8(Sc, 1);
                if (g < 7) Sc = Sn;
                __builtin_amdgcn_sched_barrier(0);
                if (g == 3 && it + 1 < ntiles) {
                    LAS unsigned char* kb2 = lds + (cur ^ 1) * DT_IMG;
                    *(LAS v4u*)(kb2 + srow * KV_PITCH + sch * 16) = kreg[0]; *(LAS v4u*)(kb2 + (srow + 64) * KV_PITCH + sch * 16) = kreg[1];
                    const int kr0 = (it + 1 < 64 ? kbase0 : kbase1) + (it + 1) * DT_ROWS;
                    const char* vb_ = (const char*)(C.P + (size_t)kr0 * INW + CC_V + hd * 64);
                    kreg[0] = *(const v4u*)(vb_ + sgoff); kreg[1] = *(const v4u*)(vb_ + (size_t)64 * INW * 2 + sgoff);
                    __builtin_amdgcn_sched_barrier(0);
                }
            }
            if (it + 1 < ntiles) { LAS unsigned char* vb2 = lds + VOFF0 + (cur ^ 1) * DV_IMG;
                *(LAS v4u*)(vb2 + srow * VP + sch * 16) = kreg[0]; *(LAS v4u*)(vb2 + (srow + 64) * VP + sch * 16) = kreg[1]; }
            __syncthreads();
        }
        O[1][0] = MFMA32(Vs[0], Pp0, O[1][0]); O[1][1] = MFMA32(Vs[2], Pp0, O[1][1]); O[1][0] = MFMA32(Vs[1], Pp1, O[1][0]); O[1][1] = MFMA32(Vs[3], Pp1, O[1][1]);
        ls0 += shx_(C.lane, ls0, 32); ls1 += shx_(C.lane, ls1, 32);
        const float inv0 = 1.f / ls0, inv1 = lam / ls1;
        float ss = 0.f;
#pragma unroll
        for (int mt = 0; mt < 2; ++mt)
#pragma unroll
            for (int i = 0; i < 16; ++i) { const float o = O[0][mt][i] * inv0 - O[1][mt][i] * inv1; O[0][mt][i] = o; ss += o * o; }
        ss += shx_(C.lane, ss, 32);
        const float rs = rsqrtf(ss * (1.f / 64.f) + EPS) * (1.f - lam_init);
        bf16* op = C.MIX + (size_t)qrow0 * 1024 + 768 + hd * 64 + (unsigned)((wave * 32 + r) * 1024);
#pragma unroll
        for (int mt = 0; mt < 2; ++mt)
#pragma unroll
            for (int g = 0; g < 4; ++g) { const int dv0 = 32 * mt + 8 * g + 4 * h; const f32x4 og = *(const f32x4*)(C.dog + l * 64 + dv0);
                v2u w; w.x = pkbf(O[0][mt][4 * g] * rs * og.x, O[0][mt][4 * g + 1] * rs * og.y); w.y = pkbf(O[0][mt][4 * g + 2] * rs * og.z, O[0][mt][4 * g + 3] * rs * og.w);
                *(v2u*)(op + dv0) = w; }
    }
}

DI void win_mfma_phase(const Args& A, int wave_s, int l, bool need_ctx, LAS unsigned char* lds) {
    const Ctx C = make_ctx(A, wave_s);
    const int lane = C.lane, wave = C.wave, r = lane & 31, h = lane >> 5;
    const float Mb2 = 8.f * 1.4426950408889634f * wave_max(C.lane, fabsf(C.wqg[l * 64 + lane])) * wave_max(C.lane, fabsf(C.wkg[l * 64 + lane]));
    const int nunits = 1024 + (need_ctx ? 32 : 0);
    const int srow = C.tid >> 3, sch = C.tid & 7;
    const int q4 = (lane & 15) >> 2, p4 = lane & 3, grp = (lane >> 4) & 1;
    const int voff = (4 * h + q4) * KV_PITCH + (16 * grp + 4 * p4) * 2;
    const int g = wave >> 1, qh = wave & 1;
    for (int u = blockIdx.x; u < nunits; u += gridDim.x) {
        int b, kv, qrow0, t0, ntiles, tfirst;
        bool lat;
        if (u < 1024) { lat = true; b = u >> 8; kv = (u >> 7) & 1; t0 = (u & 127) * 64; qrow0 = b * LSEQ + t0; }
        else { lat = false; const int uu = u - 1024; b = uu >> 3; kv = (uu >> 2) & 1; t0 = (uu & 3) * 64; qrow0 = NLAT + b * LCTX + t0; }
        const int ilo = lat ? (t0 >= 128 ? 0 : (t0 >= 64 ? 1 : 2)) : 5, ihi = lat ? (t0 + 128 < LSEQ ? 4 : (t0 + 64 < LSEQ ? 3 : 2)) : 4;
        const int nloc = lat ? (ihi - ilo + 1) : 0;
        ntiles = nloc + 4; tfirst = ilo;
        const int head = kv * 4 + g;
        const int tq = t0 + qh * 32 + r;
        const bf16* qp = C.P + (size_t)(qrow0 + qh * 32 + r) * INW + CA_Q + head * 64;
        bf16x8 Qf[4];
#pragma unroll
        for (int s = 0; s < 4; ++s) Qf[s] = *(const bf16x8*)(qp + s * 16 + h * 8);
        f32x16 O[2];
#pragma unroll
        for (int mt = 0; mt < 2; ++mt)
#pragma unroll
            for (int i = 0; i < 16; ++i) O[mt][i] = 0.f;
        float ls = 0.f;
        v4u kreg, vreg, kreg2, vreg2;
        auto tile_row = [&](int it) -> int { return it < nloc ? b * LSEQ + t0 + 64 * (tfirst + it - 2) : NLAT + b * LCTX + 64 * (it - nloc); };
        { const bf16* kr = C.P + (size_t)(tile_row(0) + srow) * INW; kreg = *(const v4u*)(kr + CA_K + kv * 64 + sch * 8); vreg = *(const v4u*)(kr + CA_V + kv * 64 + sch * 8); }
        { const bf16* kr = C.P + (size_t)(tile_row(1) + srow) * INW; kreg2 = *(const v4u*)(kr + CA_K + kv * 64 + sch * 8); vreg2 = *(const v4u*)(kr + CA_V + kv * 64 + sch * 8); }
        __syncthreads();
        *(LAS v4u*)(lds + srow * KV_PITCH + sch * 16) = kreg; *(LAS v4u*)(lds + 2 * KV_IMG + srow * KV_PITCH + sch * 16) = vreg;
        kreg = kreg2; vreg = vreg2;
        __syncthreads();
        for (int it = 0; it < ntiles; ++it) {
            const int cur = it & 1;
            if (it + 2 < ntiles) { const bf16* kr = C.P + (size_t)(tile_row(it + 2) + srow) * INW; kreg2 = *(const v4u*)(kr + CA_K + kv * 64 + sch * 8); vreg2 = *(const v4u*)(kr + CA_V + kv * 64 + sch * 8); }
            LAS unsigned char* Kb = lds + cur * KV_IMG; LAS unsigned char* Vb = lds + 2 * KV_IMG + cur * KV_IMG;
            const bool local = it < nloc; const int tk0 = t0 + 64 * (tfirst + it - 2);
            const bool edge = local && (tfirst + it == 0 || tfirst + it == 4);
#pragma unroll
            for (int sub = 0; sub < 2; ++sub) {
                f32x16 S;
#pragma unroll
                for (int i = 0; i < 16; ++i) S[i] = -Mb2;
#pragma unroll
                for (int s = 0; s < 4; ++s) { const bf16x8 kf = *(LAS bf16x8*)(Kb + (32 * sub + r) * KV_PITCH + s * 32 + h * 16); S = MFMA32(kf, Qf[s], S); }
                float t = 0.f;
#pragma unroll
                for (int i = 0; i < 16; ++i) { float e = __builtin_amdgcn_exp2f(S[i]);
                    if (edge) { const int tk = tk0 + 32 * sub + (i & 3) + 8 * (i >> 2) + 4 * h; const int d = tq - tk; e = (d > 128 || d < -128) ? 0.f : e; }
                    S[i] = e; t += e; }
                ls += t;
                const bf16x8 P0 = PACK8(S, 0), P1 = PACK8(S, 1);
#pragma unroll
                for (int mt = 0; mt < 2; ++mt) {
                    const bf16x8 v0 = tr_pair(Vb + (32 * sub) * KV_PITCH + voff + mt * 64);
                    const bf16x8 v1 = tr_pair(Vb + (32 * sub + 16) * KV_PITCH + voff + mt * 64);
                    O[mt] = MFMA32(v0, P0, O[mt]); O[mt] = MFMA32(v1, P1, O[mt]);
                }
            }
            if (it + 1 < ntiles) { *(LAS v4u*)(lds + (cur ^ 1) * KV_IMG + srow * KV_PITCH + sch * 16) = kreg; *(LAS v4u*)(lds + 2 * KV_IMG + (cur ^ 1) * KV_IMG + srow * KV_PITCH + sch * 16) = vreg; kreg = kreg2; vreg = vreg2; }
            __syncthreads();
        }
        ls += shx_(C.lane, ls, 32);
        const float inv = 1.f / (ls + __builtin_amdgcn_exp2f(C.wsink[l * 8 + head] * 1.4426950408889634f - Mb2));
        bf16* op = C.MIX + (size_t)(qrow0 + qh * 32 + r) * 1024 + head * 64;
#pragma unroll
        for (int mt = 0; mt < 2; ++mt)
#pragma unroll
            for (int gg = 0; gg < 4; ++gg) { const int dv0 = 32 * mt + 8 * gg + 4 * h;
                v2u w; w.x = pkbf(O[mt][4 * gg] * inv, O[mt][4 * gg + 1] * inv); w.y = pkbf(O[mt][4 * gg + 2] * inv, O[mt][4 * gg + 3] * inv);
                *(v2u*)(op + dv0) = w; }
    }
}


constexpr size_t WS_DEC = 452 * MiB;
constexpr int HG_IMG = 64 * KV_PITCH;
DI bf16x8 tr_nat(LAS unsigned char* img, int rowbase, int colbase, int lane) {
    const int h = lane >> 5, q4 = (lane & 15) >> 2, p4 = lane & 3, grp = (lane >> 4) & 1;
    LAS unsigned char* p = img + (rowbase + 8 * h + q4) * KV_PITCH + (colbase + 16 * grp + 4 * p4) * 2;
    const s16x4 lo = __builtin_amdgcn_ds_read_tr16_b64_v4i16((LAS s16x4*)p), hi = __builtin_amdgcn_ds_read_tr16_b64_v4i16((LAS s16x4*)(p + 4 * KV_PITCH));
    return __builtin_shufflevector(lo, hi, 0, 1, 2, 3, 4, 5, 6, 7);
}
DI int hg_rowbase(int b, int tc) { return tc < 4 ? NLAT + b * LCTX + 64 * tc : b * LSEQ + 64 * (tc - 4); }
DI int hg_scan_n(int tc, int dir) { return tc < 4 ? (dir ? 3 - tc : tc) : (dir ? 4 + (131 - tc) : tc); }

template <int MODE> DI void hgrn_chunk_phase(const Args& A, int wave_s, int l, bool need_ctx, LAS unsigned char* lds) {
    const Ctx C = make_ctx(A, wave_s);
    const int lane = C.lane, wave = C.wave, dir = wave >> 2, iq = wave & 3, r = lane & 31, h5 = lane >> 5;
    float* DEC = (float*)(C.ws + WS_DEC);
    LAS float* qt = (LAS float*)(lds + 131072);
    LAS unsigned char* img = lds + dir * (5 * HG_IMG);
    LAS float* OX = (LAS float*)(lds + 10 * HG_IMG);
    const int ntc = (MODE == 0 || need_ctx) ? 132 : 128, tc0 = (MODE == 0 || need_ctx) ? 0 : 4;
    const int nunits = 16 * ntc;
    const int kp = lane & 31, e8 = (wave & 3) * 2 + (lane >> 5);
    unsigned npf[8], nv[8], nq[8], nsp[8];
#define HG_UNIT(uu, bh_, tc_, b_, hd_, rbase_, n_, seq_) const int bh_ = (uu) / ntc, tc_ = tc0 + (uu) % ntc, b_ = bh_ >> 2, hd_ = bh_ & 3; \
        const int rbase_ = hg_rowbase(b_, tc_), n_ = hg_scan_n(tc_, dir), seq_ = (dir * 4 + b_) * 4 + hd_;
#define HG_FETCH(uu) do { HG_UNIT(uu, fbh, ftc, fb, fhd, frb, fn, fseq) \
        const int fq_ = (dir ? CB_QB : CB_QF) + fhd * 64 + 2 * kp, ff_ = (dir ? CB_FB : CB_FF) + fhd * 64 + 2 * kp, fi_ = CB_I + fhd * 64 + 2 * kp; \
        _Pragma("unroll") for (int ii = 0; ii < 8; ++ii) { const int i = e8 * 8 + ii; const int row = dir ? frb + 63 - i : frb + i; const bf16* pr_ = C.P + (size_t)row * INW; \
            npf[ii] = *(const unsigned*)(pr_ + ff_); nv[ii] = *(const unsigned*)(pr_ + fi_); nq[ii] = (MODE == 1) ? *(const unsigned*)(pr_ + fq_) : 0u; } \
        if (MODE == 1) { const bf16* sl_ = (const bf16*)C.ST + ((size_t)(fseq * 132 + fn)) * 4096; _Pragma("unroll") for (int ii = 0; ii < 8; ++ii) nsp[ii] = *(const unsigned*)(sl_ + (e8 * 8 + ii) * 64 + 2 * kp); } } while (0)
    if ((int)blockIdx.x < nunits) HG_FETCH((int)blockIdx.x);
    for (int u = blockIdx.x; u < nunits; u += gridDim.x) {
        HG_UNIT(u, bh, tc, b, hd, rbase, n, seq)
        (void)bh; (void)b;
        const float lb0 = C.SM[SM_LOWER + (l * 2 + dir) * 256 + hd * 64 + 2 * kp], lb1 = C.SM[SM_LOWER + (l * 2 + dir) * 256 + hd * 64 + 2 * kp + 1];
        float cum0[8], cum1[8], kk0[8], kk1[8]; float bl0 = 0.f, bl1 = 0.f;
        unsigned vraw[8], qraw[8], spv[8];
#pragma unroll
        for (int ii = 0; ii < 8; ++ii) {
            const float pf0 = __builtin_bit_cast(float, npf[ii] << 16), pf1 = __builtin_bit_cast(float, npf[ii] & 0xffff0000u);
            const float f0 = fmaxf(lb0 + (1.f - lb0) * sigmoid_f(pf0), 1e-30f), f1 = fmaxf(lb1 + (1.f - lb1) * sigmoid_f(pf1), 1e-30f);
            bl0 += __logf(f0); bl1 += __logf(f1); cum0[ii] = bl0; cum1[ii] = bl1; kk0[ii] = 1.f - f0; kk1[ii] = 1.f - f1;
            vraw[ii] = nv[ii]; qraw[ii] = nq[ii]; spv[ii] = nsp[ii]; }
        bf16* SL = (bf16*)C.ST + ((size_t)(seq * 132 + n)) * 4096;
        if (u + (int)gridDim.x < nunits) HG_FETCH(u + (int)gridDim.x);
        __syncthreads();
        LAS fv2* qt2 = (LAS fv2*)qt;
        qt2[(dir * 8 + e8) * 32 + kp] = (fv2){bl0, bl1};
        __syncthreads();
        float off0 = 0.f, off1 = 0.f, bref0 = 0.f, bref1 = 0.f, bend0 = 0.f, bend1 = 0.f;
#pragma unroll
        for (int j = 0; j < 8; ++j) { const fv2 tq = qt2[(dir * 8 + j) * 32 + kp];
            if (j < e8) { off0 += tq.x; off1 += tq.y; }
            if (j < 4) { bref0 += tq.x; bref1 += tq.y; }
            bend0 += tq.x; bend1 += tq.y; }
#pragma unroll
        for (int ii = 0; ii < 8; ++ii) { const int i = e8 * 8 + ii; const float bi0 = off0 + cum0[ii], bi1 = off1 + cum1[ii];
            if (MODE == 0) {
                *(LAS unsigned*)(img + i * KV_PITCH + kp * 4) = pk2(kk0[ii] * __expf(bend0 - bi0), kk1[ii] * __expf(bend1 - bi1));
                *(LAS unsigned*)(img + HG_IMG + i * KV_PITCH + kp * 4) = vraw[ii];
            } else {
                const float q0 = __builtin_bit_cast(float, qraw[ii] << 16), q1 = __builtin_bit_cast(float, qraw[ii] & 0xffff0000u);
                *(LAS unsigned*)(img + i * KV_PITCH + kp * 4) = pk2(q0 * __expf(fminf(bi0 - bref0, 80.f)), q1 * __expf(fminf(bi1 - bref1, 80.f)));
                *(LAS unsigned*)(img + HG_IMG + i * KV_PITCH + kp * 4) = pk2(kk0[ii] * __expf(fminf(bref0 - bi0, 80.f)), kk1[ii] * __expf(fminf(bref1 - bi1, 80.f)));
                *(LAS unsigned*)(img + 2 * HG_IMG + i * KV_PITCH + kp * 4) = pk2(q0 * __expf(bi0), q1 * __expf(bi1));
                *(LAS unsigned*)(img + 3 * HG_IMG + i * KV_PITCH + kp * 4) = vraw[ii];
            }
        }
        if (MODE == 0) { if (e8 == 0) *(fv2*)(DEC + (seq * 132 + n) * 64 + 2 * kp) = (fv2){__expf(bend0), __expf(bend1)}; }
        else {
#pragma unroll
            for (int ii = 0; ii < 8; ++ii) { const int k = e8 * 8 + ii; *(LAS unsigned*)(img + 4 * HG_IMG + k * KV_PITCH + kp * 4) = spv[ii]; }
        }
        __syncthreads();
        if (MODE == 0) {
            const int kblk = (wave >> 1) & 1, dvblk = wave & 1;
            f32x16 S;
#pragma unroll
            for (int i = 0; i < 16; ++i) S[i] = 0.f;
#pragma unroll
            for (int is = 0; is < 4; ++is) { const bf16x8 a = tr_nat(img, 16 * is, 32 * kblk, lane), bb = tr_nat(img + HG_IMG, 16 * is, 32 * dvblk, lane); S = MFMA32(a, bb, S); }
#pragma unroll
            for (int i = 0; i < 16; ++i) { const int k = 32 * kblk + (i & 3) + 8 * (i >> 2) + 4 * h5; SL[k * 64 + 32 * dvblk + r] = (bf16)f2bf(S[i]); }
        } else {
            const int tblk = (wave >> 1) & 1, mt = wave & 1;
            LAS unsigned char* QP = img; LAS unsigned char* KP = img + HG_IMG; LAS unsigned char* QQ = img + 2 * HG_IMG; LAS unsigned char* VI = img + 3 * HG_IMG; LAS unsigned char* SP = img + 4 * HG_IMG;
            const int q4 = (lane & 15) >> 2, p4 = lane & 3, grp = (lane >> 4) & 1;
            const int voff = (4 * h5 + q4) * KV_PITCH + (16 * grp + 4 * p4) * 2;
            f32x16 O;
#pragma unroll
            for (int i = 0; i < 16; ++i) O[i] = 0.f;
#pragma unroll
            for (int sblk = 0; sblk < 2; ++sblk) {
                if (sblk <= tblk) {
                    f32x16 AT;
#pragma unroll
                    for (int i = 0; i < 16; ++i) AT[i] = 0.f;
#pragma unroll
                    for (int ks = 0; ks < 4; ++ks) { const bf16x8 a = *(LAS bf16x8*)(KP + (32 * sblk + r) * KV_PITCH + ks * 32 + h5 * 16), bq = *(LAS bf16x8*)(QP + (32 * tblk + r) * KV_PITCH + ks * 32 + h5 * 16); AT = MFMA32(a, bq, AT); }
                    if (sblk == tblk) {
#pragma unroll
                        for (int i = 0; i < 16; ++i) { const int sp = (i & 3) + 8 * (i >> 2) + 4 * h5; AT[i] = (sp <= r) ? AT[i] : 0.f; }
                    }
                    const bf16x8 P0 = PACK8(AT, 0), P1 = PACK8(AT, 1);
                    const bf16x8 v0 = tr_pair(VI + (32 * sblk) * KV_PITCH + voff + mt * 64), v1 = tr_pair(VI + (32 * sblk + 16) * KV_PITCH + voff + mt * 64);
                    O = MFMA32(v0, P0, O); O = MFMA32(v1, P1, O);
                }
            }
#pragma unroll
            for (int ks = 0; ks < 4; ++ks) { const bf16x8 a = tr_nat(SP, 16 * ks, 32 * mt, lane), bq = *(LAS bf16x8*)(QQ + (32 * tblk + r) * KV_PITCH + ks * 32 + h5 * 16); O = MFMA32(a, bq, O); }
            const int pos = 32 * tblk + r, tloc = dir ? 63 - pos : pos;
#pragma unroll
            for (int i = 0; i < 16; ++i) { const int dv = 32 * mt + (i & 3) + 8 * (i >> 2) + 4 * h5; OX[(dir * 64 + tloc) * 68 + dv] = O[i]; }
            __syncthreads();
            {
                const int t = C.tid >> 3, part = C.tid & 7; const int row = rbase + t;
                float tot[8]; float ss = 0.f;
#pragma unroll
                for (int e = 0; e < 8; ++e) { tot[e] = OX[t * 68 + part * 8 + e] + OX[(64 + t) * 68 + part * 8 + e]; ss += tot[e] * tot[e]; }
                ss += shx_(C.lane, ss, 1); ss += shx_(C.lane, ss, 2); ss += shx_(C.lane, ss, 4);
                const float rs = rsqrtf(ss * (1.f / 64.f) + EPS);
                const v4u gr = *(const v4u*)(C.P + (size_t)row * INW + CB_G + hd * 64 + part * 8);
                unsigned res[4];
#pragma unroll
                for (int q = 0; q < 4; ++q) { const float g0 = __builtin_bit_cast(float, gr[q] << 16), g1 = __builtin_bit_cast(float, gr[q] & 0xffff0000u);
                    const float y0 = tot[2 * q] * rs * C.hgog[l * 64 + part * 8 + 2 * q] * silu_f(g0), y1 = tot[2 * q + 1] * rs * C.hgog[l * 64 + part * 8 + 2 * q + 1] * silu_f(g1);
                    res[q] = pkbf(y0, y1); }
                v4u o; o.x = res[0]; o.y = res[1]; o.z = res[2]; o.w = res[3];
                *(v4u*)(C.MIX + (size_t)row * 1024 + 512 + hd * 64 + part * 8) = o;
            }
        }
    }
    __syncthreads();
}
DI void hgrn_scan_phase(const Args& A, int wave_s) {
    const Ctx C = make_ctx(A, wave_s);
    const float* DEC = (const float*)(C.ws + WS_DEC);
    for (int gid = blockIdx.x * 512 + C.tid; gid < 32 * 2048; gid += gridDim.x * 512) {
        const int seq = gid >> 11, e = gid & 2047, k = e >> 5;
        unsigned* SL = (unsigned*)C.ST + (size_t)seq * 132 * 2048 + e; const float* D = DEC + seq * 132 * 64 + k;
        float s0 = 0.f, s1 = 0.f;
        for (int n = 0; n < 132; n += 12) {
            unsigned sl[12]; float d[12];
#pragma unroll
            for (int j = 0; j < 12; ++j) { sl[j] = SL[(size_t)(n + j) * 2048]; d[j] = D[(n + j) * 64]; }
#pragma unroll
            for (int j = 0; j < 12; ++j) { SL[(size_t)(n + j) * 2048] = pk2(s0, s1);
                s0 = d[j] * s0 + __builtin_bit_cast(float, sl[j] << 16); s1 = d[j] * s1 + __builtin_bit_cast(float, sl[j] & 0xffff0000u); }
        }
    }
}

DI void conv_phase(const Args& A, int wave_s, int l, int j, int rows) {
    const Ctx C = make_ctx(A, wave_s);
    const float* cw = C.conv_w + (size_t)l * 3 * 5632; const float* cb = C.conv_b + (size_t)l * 5632;
    const int total = rows * 176;
    for (int e = blockIdx.x * 512 + C.tid; e < total; e += gridDim.x * 512) {
        const int m = e / 176, c8 = (e % 176) * 8;
        bool first, last;
        if (m < NLAT) { first = (m & 8191) == 0; last = (m & 8191) == 8191; } else { first = ((m - NLAT) & 255) == 0; last = ((m - NLAT) & 255) == 255; }
        const bf16* u1 = C.U + (size_t)m * DFF;
        v4u z = {0u, 0u, 0u, 0u};
        const v4u a0 = first ? z : *(const v4u*)(u1 - DFF + c8), a1 = *(const v4u*)(u1 + c8), a2 = last ? z : *(const v4u*)(u1 + DFF + c8);
        const v4u b0 = first ? z : *(const v4u*)(u1 - DFF + DFFH + c8), b1 = *(const v4u*)(u1 + DFFH + c8), b2 = last ? z : *(const v4u*)(u1 + DFF + DFFH + c8);
        const int na = j * DFFH + c8, nv = DFF + j * DFFH + c8;
        unsigned res[4];
#pragma unroll
        for (int q = 0; q < 4; ++q) {
            float r2[2];
#pragma unroll
            for (int hlf = 0; hlf < 2; ++hlf) {
                const int i = 2 * q + hlf;
                const float ua0 = hlf ? __builtin_bit_cast(float, a0[q] & 0xffff0000u) : __builtin_bit_cast(float, a0[q] << 16);
                const float ua1 = hlf ? __builtin_bit_cast(float, a1[q] & 0xffff0000u) : __builtin_bit_cast(float, a1[q] << 16);
                const float ua2 = hlf ? __builtin_bit_cast(float, a2[q] & 0xffff0000u) : __builtin_bit_cast(float, a2[q] << 16);
                const float ub0 = hlf ? __builtin_bit_cast(float, b0[q] & 0xffff0000u) : __builtin_bit_cast(float, b0[q] << 16);
                const float ub1 = hlf ? __builtin_bit_cast(float, b1[q] & 0xffff0000u) : __builtin_bit_cast(float, b1[q] << 16);
                const float ub2 = hlf ? __builtin_bit_cast(float, b2[q] & 0xffff0000u) : __builtin_bit_cast(float, b2[q] << 16);
                const float ya = cb[na + i] + ua0 * cw[na + i] + ua1 * cw[5632 + na + i] + ua2 * cw[2 * 5632 + na + i];
                const float yv = cb[nv + i] + ub0 * cw[nv + i] + ub1 * cw[5632 + nv + i] + ub2 * cw[2 * 5632 + nv + i];
                r2[hlf] = silu_f(ya) * yv;
            }
            res[q] = pk2(r2[0], r2[1]);
        }
        v4u o; o.x = res[0]; o.y = res[1]; o.z = res[2]; o.w = res[3];
        *(v4u*)(C.ACT + (size_t)m * DFFH + c8) = o;
    }
}


DI void ffn_fixup_phase(const Args& A, int wave_s, int l, int rows) {
    const Ctx C = make_ctx(A, wave_s);
    const float* cw = C.conv_w + (size_t)l * 3 * 5632; const float* cb = C.conv_b + (size_t)l * 5632;
    const bf16* UB = C.ACT;
    bf16* ACTF = C.U;
    const int nkb = rows / 64, total = nkb * 2 * 352;
    for (int e = blockIdx.x * 512 + C.tid; e < total; e += gridDim.x * 512) {
        const int c8 = (e % 352) * 8, rs = e / 352, side = rs & 1, kb = rs >> 1;
        const int R = kb * 64 + (side ? 63 : 0);
        bool first, last;
        if (R < NLAT) { first = (R & 8191) == 0; last = (R & 8191) == 8191; } else { first = ((R - NLAT) & 255) == 0; last = ((R - NLAT) & 255) == 255; }
        const v4u z = {0u, 0u, 0u, 0u};
        const bf16* pp = side ? UB + (size_t)((kb * 4 + 2) * 2) * 2816 : UB + (size_t)(((kb - 1) * 4 + 3) * 2) * 2816;
        const bf16* pc = UB + (size_t)((kb * 4 + (side ? 3 : 0)) * 2) * 2816;
        const bf16* pn = side ? UB + (size_t)(((kb + 1) * 4 + 0) * 2) * 2816 : UB + (size_t)((kb * 4 + 1) * 2) * 2816;
        const bool zp = (!side) && first, zn = side && last;
        const v4u a0 = zp ? z : *(const v4u*)(pp + c8), a1 = *(const v4u*)(pc + c8), a2 = zn ? z : *(const v4u*)(pn + c8);
        const v4u b0 = zp ? z : *(const v4u*)(pp + 2816 + c8), b1 = *(const v4u*)(pc + 2816 + c8), b2 = zn ? z : *(const v4u*)(pn + 2816 + c8);
        unsigned res[4];
#pragma unroll
        for (int q = 0; q < 4; ++q) {
            float r2[2];
#pragma unroll
            for (int hlf = 0; hlf < 2; ++hlf) {
                const int i = c8 + 2 * q + hlf;
                const float ua0 = hlf ? __builtin_bit_cast(float, a0[q] & 0xffff0000u) : __builtin_bit_cast(float, a0[q] << 16);
                const float ua1 = hlf ? __builtin_bit_cast(float, a1[q] & 0xffff0000u) : __builtin_bit_cast(float, a1[q] << 16);
                const float ua2 = hlf ? __builtin_bit_cast(float, a2[q] & 0xffff0000u) : __builtin_bit_cast(float, a2[q] << 16);
                const float ub0 = hlf ? __builtin_bit_cast(float, b0[q] & 0xffff0000u) : __builtin_bit_cast(float, b0[q] << 16);
                const float ub1 = hlf ? __builtin_bit_cast(float, b1[q] & 0xffff0000u) : __builtin_bit_cast(float, b1[q] << 16);
                const float ub2 = hlf ? __builtin_bit_cast(float, b2[q] & 0xffff0000u) : __builtin_bit_cast(float, b2[q] << 16);
                const float ya = cb[i] + ua0 * cw[i] + ua1 * cw[5632 + i] + ua2 * cw[2 * 5632 + i];
                const float yv = cb[2816 + i] + ub0 * cw[2816 + i] + ub1 * cw[5632 + 2816 + i] + ub2 * cw[2 * 5632 + 2816 + i];
                r2[hlf] = silu_f(ya) * yv;
            }
            res[q] = pk2(r2[0], r2[1]);
        }
        v4u o; o.x = res[0]; o.y = res[1]; o.z = res[2]; o.w = res[3];
        *(v4u*)(ACTF + (size_t)R * 2816 + c8) = o;
    }
}

typedef __attribute__((address_space(1))) unsigned gu32;
#define RLX_AGENT __ATOMIC_RELAXED, __HIP_MEMORY_SCOPE_AGENT
#define LDS_WAIT() asm volatile("s_waitcnt lgkmcnt(0)" ::: "memory")
#define VM_WAIT() asm volatile("s_waitcnt vmcnt(0)" ::: "memory")
#define XB_TMO      128
#define XB_XCNT(j)  (256  + 64 * (j))
#define XB_XSUB(j)  (1280 + 64 * (j))
#define XB_XGEN(j)  (2304 + 64 * (j))
#define XB_TOP      3328
#define XB_TOPGEN   3392
#define XCD_BAR_WORDS 3456
#define XB_SPIN_CAP (1u << 18)

__device__ __forceinline__ unsigned xb_ld(unsigned* p)              { return __hip_atomic_load(p, __ATOMIC_RELAXED, __HIP_MEMORY_SCOPE_AGENT); }
__device__ __forceinline__ unsigned xb_add(unsigned* p, unsigned v) { return __hip_atomic_fetch_add(p, v, __ATOMIC_RELAXED, __HIP_MEMORY_SCOPE_AGENT); }
__device__ __forceinline__ unsigned xb_xcc_id() { return (unsigned)__builtin_amdgcn_s_getreg((3 << 11) | 20) & 0xFu; }
#define XB_SPIN(cond, bar) do { unsigned _sp = 0; while (cond) { __builtin_amdgcn_s_sleep(6);   \
    if ((++_sp & 255u) == 0u) { if (xb_ld(&(bar)[XB_TMO])) break; if (_sp > XB_SPIN_CAP) { atomicAdd(&(bar)[XB_TMO], 1u); break; } } } } while (0)

struct XcdBarrier {
    unsigned* bar; unsigned x;
    volatile LAS unsigned* st;
};

__device__ __forceinline__ XcdBarrier xcd_barrier_post(unsigned* bar, volatile LAS unsigned* st, int xtid) {
    XcdBarrier b; b.bar = bar; b.x = xb_xcc_id(); b.st = st;
    if (xtid == 0) (void)xb_add(&bar[XB_XCNT(b.x)], 1u);
    return b;
}
__device__ __forceinline__ void xcd_barrier_complete(unsigned* bar, unsigned x, unsigned& nloc, unsigned& nx) {
    const unsigned G = gridDim.x * gridDim.y * gridDim.z;
    unsigned sum, cnt, mine, sp = 0u;
    for (;;) {
        sum = 0u; cnt = 0u; mine = 0u;
#pragma unroll
        for (unsigned j = 0; j < 16; ++j) { const unsigned c = xb_ld(&bar[XB_XCNT(j)]); sum += c; cnt += (c > 0u) ? 1u : 0u; mine = (j == x) ? c : mine; }
        if (sum == G) break;
        __builtin_amdgcn_s_sleep(1);
        if ((++sp & 255u) == 0u) { if (xb_ld(&bar[XB_TMO])) break; if (sp > XB_SPIN_CAP) { atomicAdd(&bar[XB_TMO], 1u); break; } }
    }
    nloc = mine > 0u ? mine : 1u; nx = cnt > 0u ? cnt : 1u;
}

__device__ __forceinline__ void xcd_barrier(const XcdBarrier& b, int xtid) {
    asm volatile("s_waitcnt vmcnt(0)" ::: "memory");
    __syncthreads();
    if (xtid == 0) {
        unsigned* bar = b.bar; unsigned bx_ = b.x; asm volatile("" : "+s"(bx_));
        __builtin_amdgcn_s_waitcnt(0);
        unsigned nloc = b.st[0], nx = b.st[1];
        if (nloc == 0u) { xcd_barrier_complete(bar, bx_, nloc, nx); b.st[0] = nloc; b.st[1] = nx; }
        const unsigned old = xb_add(&bar[XB_XSUB(bx_)], 1u);
        const unsigned gen = old / nloc;
        if (old + 1u == (gen + 1u) * nloc) {
            __builtin_amdgcn_fence(__ATOMIC_RELEASE, "agent");
            asm volatile("s_waitcnt vmcnt(0)" ::: "memory");
            const unsigned og = xb_add(&bar[XB_TOP], 1u);
            const unsigned tg = og / nx;
            if (og + 1u == (tg + 1u) * nx) xb_add(&bar[XB_TOPGEN], 1u);
            else XB_SPIN(xb_ld(&bar[XB_TOPGEN]) == tg, bar);
            __builtin_amdgcn_fence(__ATOMIC_ACQUIRE, "agent");
            xb_add(&bar[XB_XGEN(bx_)], 1u);
            asm volatile("s_waitcnt vmcnt(0)" ::: "memory");
        } else {
            XB_SPIN(xb_ld(&bar[XB_XGEN(bx_)]) == gen, bar);
            __builtin_amdgcn_fence(__ATOMIC_ACQUIRE, "agent");
            asm volatile("s_waitcnt vmcnt(0)" ::: "memory");
        }
    }
    __syncthreads();
}

#if PROBE_SYNC2
#define GSYNC() do { xcd_barrier(xbar, wave_s * 64 + fresh_lane()); xcd_barrier(xbar, wave_s * 64 + fresh_lane()); } while (0)
#else
#define GSYNC() xcd_barrier(xbar, wave_s * 64 + fresh_lane())
#endif
__global__ void __launch_bounds__(512, 2) fwd_kernel(Args args) {
    extern __shared__ __attribute__((aligned(16))) unsigned char lds_raw[];
    LAS unsigned char* lds = (LAS unsigned char*)lds_raw;
    cg::grid_group grid = cg::this_grid();
    const int G = gridDim.x, bx = blockIdx.x;

    if (threadIdx.x < 4) ((volatile LAS unsigned*)(lds + 139264))[threadIdx.x] = 0u;
    __syncthreads();
    const int wave_s = __builtin_amdgcn_readfirstlane(threadIdx.x >> 6);
    XcdBarrier xbar = xcd_barrier_post((unsigned*)args.ws + 1024, (volatile LAS unsigned*)(lds + 139264), (int)threadIdx.x);
    p0_phase(args, wave_s, lds);
    p0_transposes(args, wave_s, lds, 0, 1536, bx * 8 + wave_s, G * 8);
    grid.sync();
    for (int l = 0; l < 2; ++l) {
        const bool need_ctx = (l == 0);
        const int Mres = need_ctx ? MTOT : NLAT;
        norm_phase(args, wave_s, l, 1, MTOT);
#if PROBE_EW2
        norm_phase(args, wave_s, l, 1, MTOT);
#endif
        GSYNC();
        { pg8::Gemm g{(const bf16*)(args.ws + WS_H), (const bf16*)(args.ws + WS_WIN) + (size_t)l * 3072 * 1024, MTOT, INW, 1024}; pg8::StaticOrder S; S.init(MTOT, INW, G, bx);
          pg8::EpiBf16 E{(bf16*)(args.ws + WS_P), INW}; pg8::gemm_phase<pg8::EpiBf16, pg8::StaticOrder, true, true>(lds, g, S, E, wave_s * 64 + fresh_lane());
#if PROBE_IN2
          pg8::gemm_phase<pg8::EpiBf16, pg8::StaticOrder, true, true>(lds, g, S, E, wave_s * 64 + fresh_lane());
#endif
          if (l == 0 && bx >= (1584 % G)) p0_transposes(args, wave_s, lds, 1536, 12544, (bx - 1584 % G) * 8 + wave_s, (G - 1584 % G) * 8);
#if PROBE_GEMM2
          pg8::gemm_phase<pg8::EpiBf16, pg8::StaticOrder, true, true>(lds, g, S, E, wave_s * 64 + fresh_lane());
#endif
        }
        GSYNC();
        prep_phase(args, wave_s, l);
        hgrn_chunk_phase<0>(args, wave_s, l, need_ctx, lds);
        GSYNC();
        hgrn_scan_phase(args, wave_s);
        win_mfma_phase(args, wave_s, l, need_ctx, lds);
        GSYNC();
        hgrn_chunk_phase<1>(args, wave_s, l, need_ctx, lds);
        diff_mfma_phase(args, wave_s, l, need_ctx, lds);
        GSYNC();
        { pg8::Gemm g{(const bf16*)(args.ws + WS_MIX), (const bf16*)(args.ws + WS_WOUT) + (size_t)l * 1024 * 1024, Mres, 1024, 1024}; pg8::StaticOrder S; S.init(Mres, 1024, G, bx);
          pg8::EpiResGate E{l == 0 ? args.in[0] : args.out, l == 0 ? args.in[2] : (const float*)(args.ws + WS_XC), args.out, (float*)(args.ws + WS_XC), (const float*)(args.ws + WS_SMALL) + SM_MOD + l * 5 * 6144 + 2048};
          pg8::gemm_phase<pg8::EpiResGate, pg8::StaticOrder, true, true>(lds, g, S, E, wave_s * 64 + fresh_lane()); }
        GSYNC();
        norm_phase(args, wave_s, l, 2, Mres);
#if PROBE_EW2
        norm_phase(args, wave_s, l, 2, Mres);
#endif
        GSYNC();
        { pg8::Gemm g{(const bf16*)(args.ws + WS_H), (const bf16*)(args.ws + WS_WUP) + (size_t)l * 5632 * 1024, Mres, 5632, 1024}; pg8::StaticOrder S; S.init(Mres, 5632, G, bx);
          pg8::EpiConvGate E{(bf16*)(args.ws + WS_U), (bf16*)(args.ws + WS_ACT), args.in[20] + (size_t)l * 3 * 5632, args.in[21] + (size_t)l * 5632};
          pg8::gemm_phase<pg8::EpiConvGate, pg8::StaticOrder, true, true>(lds, g, S, E, wave_s * 64 + fresh_lane());
#if PROBE_UP2
          pg8::gemm_phase<pg8::EpiConvGate, pg8::StaticOrder, true, true>(lds, g, S, E, wave_s * 64 + fresh_lane());
#endif
        }
        GSYNC();
        ffn_fixup_phase(args, wave_s, l, Mres);
        GSYNC();
        { pg8::Gemm g{(const bf16*)(args.ws + WS_U), (const bf16*)(args.ws + WS_WDN) + (size_t)l * 2816 * 1024, Mres, 1024, DFF}; pg8::StaticOrder S; S.init(Mres, 1024, G, bx);
          pg8::EpiResGate E{args.out, (const float*)(args.ws + WS_XC), args.out, (float*)(args.ws + WS_XC), (const float*)(args.ws + WS_SMALL) + SM_MOD + l * 5 * 6144 + 5120};
          pg8::gemm_phase<pg8::EpiResGate, pg8::StaticOrder, true, true>(lds, g, S, E, wave_s * 64 + fresh_lane()); }
        GSYNC();
    }
}

extern "C" void kernel_launch(void* const* d_in, const int* in_sizes, int n_in, void* d_out, int out_size, void* d_ws, size_t ws_size, hipStream_t stream) {
    static int grid = 0;
    if (grid == 0) {
        if (n_in != 23 || ws_size < WS_END) { fprintf(stderr, "kernel_launch: bad args n_in %d ws %zu\n", n_in, ws_size); grid = -1; return; }
        int dev = 0, cus = 0, per_cu = 0;
        (void)hipGetDevice(&dev); (void)hipDeviceGetAttribute(&cus, hipDeviceAttributeMultiprocessorCount, dev);
        (void)hipFuncSetAttribute((const void*)fwd_kernel, hipFuncAttributeMaxDynamicSharedMemorySize, LDS_BYTES);
        (void)hipOccupancyMaxActiveBlocksPerMultiprocessor(&per_cu, (const void*)fwd_kernel, 512, LDS_BYTES);
        if (per_cu < 1) per_cu = 1;
        grid = cus;
        (void)hipGetLastError();
    }
    if (grid < 0) return;
    if (hipMemsetAsync(d_ws, 0, 65536, stream) != hipSuccess) { fprintf(stderr, "memset failed\n"); return; }
    Args a{};
    for (int i = 0; i < 23; ++i) a.in[i] = (const float*)d_in[i];
    a.out = (float*)d_out; a.ws = (unsigned char*)d_ws;
    void* params[] = {&a};
    hipError_t e = hipLaunchCooperativeKernel((const void*)fwd_kernel, dim3(grid), dim3(512), params, LDS_BYTES, stream);
    if (e != hipSuccess) fprintf(stderr, "cooperative launch failed: %s (grid %d)\n", hipGetErrorString(e), grid);
}
```

```cpp
#include <hip/hip_runtime.h>
#include <hip/hip_cooperative_groups.h>
#include <cstdio>
#include <cstdint>
namespace cg = cooperative_groups;
#ifndef PROBE_DIFF2
#define PROBE_DIFF2 0
#endif
#ifndef PROBE_WIN2
#define PROBE_WIN2 0
#endif
#ifndef PROBE_SYNC2
#define PROBE_SYNC2 0
#endif
#ifndef PROBE_GEMM2
#define PROBE_GEMM2 0
#endif
#ifndef PROBE_HG2
#define PROBE_HG2 0
#endif
#ifndef PROBE_EW2
#define PROBE_EW2 0
#endif
#ifndef PROBE_P02
#define PROBE_P02 0
#endif
#ifndef PROBE_IN2
#define PROBE_IN2 0
#endif
#ifndef PROBE_UP2
#define PROBE_UP2 0
#endif
namespace pg8 {
#define PG8_LAS __attribute__((address_space(3)))
typedef unsigned short bf16_t;
typedef short bf16x8 __attribute__((ext_vector_type(8)));
typedef float f32x4 __attribute__((ext_vector_type(4)));
typedef unsigned u32x4 __attribute__((ext_vector_type(4)));
constexpr int BM = 256, BK = 64, HALF = 128, HTB = HALF * BK * 2  , STAGE_BYTES = 8 * HTB, NXCD = 8, WGM = 8;

__host__ __device__ __forceinline__ int lds_byte(int r, int c) { const int st = (r >> 4) * 2 + (c >> 5), rr = r & 15, cc = c & 31, ob = rr * 64 + cc * 2; return st * 1024 + (ob ^ (((ob >> 9) & 1) << 5)); }
__host__ __device__ __forceinline__ void stage_rc(int b, int& R, int& C) { const int st = b / 1024, sb = b % 1024, swz = sb ^ (((sb >> 9) & 1) << 5); R = (st >> 1) * 16 + swz / 64; C = (st & 1) * 32 + (swz % 64) / 2; }
__host__ __device__ __forceinline__ int perm32(int rho) { const int n = rho >> 4, i = rho & 15; return 8 * (i >> 2) + 4 * n + (i & 3); }

struct Unit { int pm, pn; };
struct Gemm { const bf16_t* A; const bf16_t* Bt; int M, N, K; };

struct StaticOrder {
    int nM, nN, nwg, G, c;
    __host__ __device__ void init(int M, int N, int G_, int c_) { nM = M / BM; nN = N / BM; nwg = nM * nN; G = G_; c = c_; }
    __host__ __device__ bool next(int i, Unit& u) const {
        const long L = (long)i * G + c; if (L >= nwg) return false;
        int wgid = (int)L; { const int q = nwg / NXCD, r = nwg % NXCD, xcd = wgid % NXCD, off = wgid / NXCD; wgid = (xcd < r ? xcd * (q + 1) : r * (q + 1) + (xcd - r) * q) + off; }
        const int nig = WGM * nN, gid = wgid / nig, fm = gid * WGM, gsz = (nM - fm) < WGM ? (nM - fm) : WGM;
        u.pm = fm + ((wgid % nig) % gsz); u.pn = (wgid % nig) / gsz; return true;
    }
    __device__ __forceinline__ void a_ready(const Unit&) const {}
    __device__ __forceinline__ void done(const Unit&) const {}
};

__device__ __forceinline__ unsigned cvt_pk_bf16(float lo, float hi) { unsigned r; asm volatile("v_cvt_pk_bf16_f32 %0, %1, %2" : "=v"(r) : "v"(lo), "v"(hi)); return r; }
typedef unsigned u32x2 __attribute__((ext_vector_type(2)));
struct EpiBf16 {
    static constexpr bool PERM = true, AFTER_DRAIN = false, APERM = false;
    bf16_t* O; int ldc;
    __device__ __forceinline__ void operator()(const f32x4 (&acc)[2][2][4][2], const Unit& u, int wr, int wc, int fr, int fq) const {
        const int row0 = u.pm * BM + wr * 64 + fr; const int col0 = u.pn * BM + wc * 32 + 8 * fq;
#pragma unroll
        for (int ai = 0; ai < 2; ++ai)
#pragma unroll
            for (int m = 0; m < 4; ++m) { bf16_t* rowp = O + (size_t)(row0 + ai * HALF + m * 16) * ldc + col0;
#pragma unroll
                for (int bj = 0; bj < 2; ++bj) { const f32x4 v0 = acc[ai][bj][m][0], v1 = acc[ai][bj][m][1];
                    u32x4 w; w.x = cvt_pk_bf16(v0[0], v0[1]); w.y = cvt_pk_bf16(v0[2], v0[3]); w.z = cvt_pk_bf16(v1[0], v1[1]); w.w = cvt_pk_bf16(v1[2], v1[3]);
                    *(u32x4*)(rowp + bj * HALF) = w; } }
    }
};
struct EpiResGate {
    static constexpr bool PERM = false, AFTER_DRAIN = false, APERM = false;
    const float* base_lat; const float* base_ctx; float* out_lat; float* out_ctx; const float* gate;
    __device__ __forceinline__ void operator()(const f32x4 (&acc)[2][2][4][2], const Unit& u, int wr, int wc, int fr, int fq) const {
        const bool isctx = u.pm >= 128;
        const int v = isctx ? 4 : (u.pm >> 5);
        const float* bp = isctx ? base_ctx - (size_t)32768 * 1024 : base_lat;
        float* op = isctx ? out_ctx - (size_t)32768 * 1024 : out_lat;
        const float* g = gate + v * 6144;
        const int row0 = u.pm * BM + wr * 64 + fr; const int col0 = u.pn * BM + wc * 32 + 4 * fq;
        f32x4 gv[2][2];
#pragma unroll
        for (int bj = 0; bj < 2; ++bj)
#pragma unroll
            for (int n = 0; n < 2; ++n) gv[bj][n] = *(const f32x4*)(g + col0 + bj * HALF + n * 16);
#pragma unroll
        for (int ai = 0; ai < 2; ++ai) {
            f32x4 bs[4][2][2];
#pragma unroll
            for (int m = 0; m < 4; ++m) { const size_t off = (size_t)(row0 + ai * HALF + m * 16) * 1024 + col0;
#pragma unroll
                for (int bj = 0; bj < 2; ++bj)
#pragma unroll
                    for (int n = 0; n < 2; ++n) bs[m][bj][n] = *(const f32x4*)(bp + off + bj * HALF + n * 16); }
#pragma unroll
            for (int m = 0; m < 4; ++m) { const size_t off = (size_t)(row0 + ai * HALF + m * 16) * 1024 + col0;
#pragma unroll
                for (int bj = 0; bj < 2; ++bj)
#pragma unroll
                    for (int n = 0; n < 2; ++n) *(f32x4*)(op + off + bj * HALF + n * 16) = bs[m][bj][n] + gv[bj][n] * acc[ai][bj][m][n]; }
            asm volatile("" ::: "memory");
        }
    }
};
__device__ __forceinline__ float dpp_ror1(float v) { return __builtin_bit_cast(float, __builtin_amdgcn_update_dpp(0, __builtin_bit_cast(int, v), 0x121, 0xF, 0xF, false)); }
__device__ __forceinline__ float dpp_ror15(float v) { return __builtin_bit_cast(float, __builtin_amdgcn_update_dpp(0, __builtin_bit_cast(int, v), 0x12F, 0xF, 0xF, false)); }
struct EpiConvGate {
    static constexpr bool PERM = true, AFTER_DRAIN = false, APERM = true;
    bf16_t* ACT; bf16_t* UB; const float* cw; const float* cb;
    __device__ __forceinline__ void operator()(const f32x4 (&acc)[2][2][4][2], const Unit& u, int wr, int wc, int fr, int fq) const {
        const int chb = u.pn * 128 + wc * 32 + 8 * fq;
        const bool f0 = fr == 0, f15 = fr == 15;
#pragma unroll
        for (int n = 0; n < 2; ++n) {
            const int ch = chb + 4 * n;
            const f32x4 w0a = *(const f32x4*)(cw + ch), w1a = *(const f32x4*)(cw + 5632 + ch), w2a = *(const f32x4*)(cw + 2 * 5632 + ch), ba = *(const f32x4*)(cb + ch);
            const f32x4 w0v = *(const f32x4*)(cw + 2816 + ch), w1v = *(const f32x4*)(cw + 5632 + 2816 + ch), w2v = *(const f32x4*)(cw + 2 * 5632 + 2816 + ch), bv = *(const f32x4*)(cb + 2816 + ch);
#pragma unroll
            for (int ai = 0; ai < 2; ++ai) {
                const int kb = u.pm * 4 + ai * 2 + wr;
                f32x4 pa0, pv0, na3, nv3;
#pragma unroll
                for (int e = 0; e < 4; ++e) { pa0[e] = dpp_ror1(acc[ai][0][3][n][e]); pv0[e] = dpp_ror1(acc[ai][1][3][n][e]); na3[e] = dpp_ror15(acc[ai][0][0][n][e]); nv3[e] = dpp_ror15(acc[ai][1][0][n][e]); }
#pragma unroll
                for (int m = 0; m < 4; ++m) {
                    const f32x4 ua = acc[ai][0][m][n], uv = acc[ai][1][m][n];
                    const f32x4 pa = (m > 0) ? acc[ai][0][m - 1][n] : pa0, na = (m < 3) ? acc[ai][0][m + 1][n] : na3;
                    const f32x4 pv = (m > 0) ? acc[ai][1][m - 1][n] : pv0, nv = (m < 3) ? acc[ai][1][m + 1][n] : nv3;
                    const f32x4 ya = ba + w0a * pa + w1a * ua + w2a * na, yv = bv + w0v * pv + w1v * uv + w2v * nv;
                    f32x4 o;
#pragma unroll
                    for (int e = 0; e < 4; ++e) o[e] = ya[e] * __builtin_amdgcn_rcpf(1.f + __builtin_amdgcn_exp2f(-1.4426950408889634f * ya[e])) * yv[e];
                    const int rowin = 4 * fr + m;
                    const bool deferred = (m == 0 && f0) || (m == 3 && f15);
                    if (!deferred) { u32x2 w; w.x = cvt_pk_bf16(o[0], o[1]); w.y = cvt_pk_bf16(o[2], o[3]); *(u32x2*)(ACT + (size_t)(kb * 64 + rowin) * 2816 + ch) = w; }
                    if ((f0 && m < 2) || (f15 && m >= 2)) { const int q = f0 ? m : m;
                        u32x2 wa, wv; wa.x = cvt_pk_bf16(ua[0], ua[1]); wa.y = cvt_pk_bf16(ua[2], ua[3]); wv.x = cvt_pk_bf16(uv[0], uv[1]); wv.y = cvt_pk_bf16(uv[2], uv[3]);
                        bf16_t* ub = UB + (size_t)((kb * 4 + q) * 2) * 2816 + ch; *(u32x2*)ub = wa; *(u32x2*)(ub + 2816) = wv; }
                }
            }
        }
    }
};
template <class Epi, class Sched, bool ALIGN_EPI = false, bool SP2 = false>
__device__ __forceinline__ void gemm_phase(PG8_LAS unsigned char* lds, const Gemm g, const Sched& S, const Epi& E, int tid_in) {
    int tid_ = tid_in; asm volatile("" : "+v"(tid_)); const int tid = tid_, wid = __builtin_amdgcn_readfirstlane(tid >> 6), lane = tid & 63, wr = wid >> 2, wc = wid & 3, fr = lane & 15, fq = lane >> 4;
    const int K = g.K, nt = K / BK;
    unsigned voffA[2], voffB[2];
#pragma unroll
    for (int i = 0; i < 2; ++i) { int R, C; stage_rc(tid * 16 + i * 8192, R, C); const int Rb = Epi::PERM ? ((R & ~31) + perm32(R & 31)) : R;
        const int Ra = Epi::APERM ? ((R & ~63) + 4 * (R & 15) + ((R & 63) >> 4)) : R;
        voffA[i] = (unsigned)(Ra * K + C) * 2u; voffB[i] = (unsigned)(Rb * K + C) * 2u; }
    const size_t kstep = (size_t)(BK * 2);
    const size_t hstep = (size_t)HALF * K * 2;
    const size_t tstep = 2 * hstep;
    const unsigned ldsw = (unsigned)wid * 1024u;
    const int aoff = lds_byte(wr * 64 + fr, fq * 8), boff = lds_byte(wc * 32 + fr, fq * 8);
#define PG8_SA(b, h) (((b) * 2 + (h)) * HTB)
#define PG8_SB(b, h) ((4 + (b) * 2 + (h)) * HTB)
#define PG8_STAGE(bufoff, gbase, voff) do { _Pragma("unroll") for (int _i = 0; _i < 2; ++_i) \
        __builtin_amdgcn_global_load_lds((const unsigned*)((const char*)(gbase) + (voff)[_i]), (PG8_LAS unsigned*)(lds + (bufoff) + ldsw + _i * 8192), 16, 0, 0); } while (0)
#define PG8_LDA(dst, b, h) do { _Pragma("unroll") for (int m = 0; m < 4; ++m) _Pragma("unroll") for (int k = 0; k < 2; ++k) dst[m][k] = *(const PG8_LAS bf16x8*)(lds + PG8_SA(b, h) + aoff + m * 2048 + k * 1024); } while (0)
#define PG8_LDB(dst, b, h) do { _Pragma("unroll") for (int n = 0; n < 2; ++n) _Pragma("unroll") for (int k = 0; k < 2; ++k) dst[n][k] = *(const PG8_LAS bf16x8*)(lds + PG8_SB(b, h) + boff + n * 2048 + k * 1024); } while (0)
#define PG8_MMA(ai, bj, At, Bt) do { __builtin_amdgcn_s_setprio(1); _Pragma("unroll") for (int m = 0; m < 4; ++m) _Pragma("unroll") for (int n = 0; n < 2; ++n) _Pragma("unroll") for (int k = 0; k < 2; ++k) \
        acc[ai][bj][m][n] = __builtin_amdgcn_mfma_f32_16x16x32_bf16(Bt[n][k], At[m][k], acc[ai][bj][m][n], 0, 0, 0); __builtin_amdgcn_s_setprio(0); } while (0)
#define PG8_WAIT_V(n) asm volatile("s_waitcnt vmcnt(" #n ")" ::: "memory")
#define PG8_WAIT_L(n) asm volatile("s_waitcnt lgkmcnt(" #n ")" ::: "memory")
#define PG8_BAR __builtin_amdgcn_s_barrier()
#define PG8_SCHED __builtin_amdgcn_sched_barrier(0)
    Unit cur, nxt; int ui = 0;
    if (!S.next(0, cur)) return;
    f32x4 acc[2][2][4][2];
#pragma unroll
    for (int a = 0; a < 2; ++a)
#pragma unroll
        for (int b = 0; b < 2; ++b)
#pragma unroll
            for (int m = 0; m < 4; ++m)
#pragma unroll
                for (int n = 0; n < 2; ++n) acc[a][b][m][n] = (f32x4){0.f, 0.f, 0.f, 0.f};
    bf16x8 At[4][2], B0[2][2], B1[2][2];
    const char* cA = (const char*)g.A + (size_t)cur.pm * tstep; const char* cB = (const char*)g.Bt + (size_t)cur.pn * tstep;
    S.a_ready(cur);
    if constexpr (SP2) {
        PG8_STAGE(PG8_SB(0, 0), cB, voffB); PG8_STAGE(PG8_SB(0, 1), cB + hstep, voffB); PG8_STAGE(PG8_SA(0, 0), cA, voffA); PG8_STAGE(PG8_SA(0, 1), cA + hstep, voffA);
        if (wr == 1) PG8_BAR;
        PG8_WAIT_V(2); PG8_BAR;
        PG8_STAGE(PG8_SB(1, 0), cB + kstep, voffB); PG8_STAGE(PG8_SA(1, 0), cA + kstep, voffA); PG8_STAGE(PG8_SB(1, 1), cB + hstep + kstep, voffB);
        PG8_WAIT_V(6); PG8_BAR;
    } else {
        PG8_STAGE(PG8_SB(0, 0), cB, voffB); PG8_STAGE(PG8_SA(0, 0), cA, voffA); PG8_STAGE(PG8_SB(0, 1), cB + hstep, voffB); PG8_STAGE(PG8_SA(0, 1), cA + hstep, voffA);
        if (wr == 1) PG8_BAR;
        PG8_WAIT_V(4); PG8_BAR;
        PG8_STAGE(PG8_SB(1, 0), cB + kstep, voffB); PG8_STAGE(PG8_SA(1, 0), cA + kstep, voffA); PG8_STAGE(PG8_SB(1, 1), cB + hstep + kstep, voffB);
        PG8_WAIT_V(6); PG8_BAR;
    }
    for (;;) {
        const bool has_next = S.next(ui + 1, nxt);
        const char* nA = has_next ? (const char*)g.A + (size_t)nxt.pm * tstep : cA; const char* nB = has_next ? (const char*)g.Bt + (size_t)nxt.pn * tstep : cB;
        for (int t = 0; t < nt; t += 2) {
            const bool last = (t == nt - 2);
            const char* a1 = cA + (size_t)(t + 1) * kstep;
            const char* a2 = last ? nA : cA + (size_t)(t + 2) * kstep; const char* b2 = last ? nB : cB + (size_t)(t + 2) * kstep;
            const char* a3 = a2 + kstep; const char* b3 = b2 + kstep;
            if (last && has_next) S.a_ready(nxt);
            if constexpr (SP2) {
            PG8_LDB(B0, 0, 0); PG8_LDB(B1, 0, 1); PG8_SCHED; PG8_LDA(At, 0, 0); PG8_STAGE(PG8_SA(1, 1), a1 + hstep, voffA);
            PG8_WAIT_V(8); PG8_WAIT_L(0); PG8_BAR; PG8_MMA(0, 0, At, B0); PG8_MMA(0, 1, At, B1); PG8_BAR; PG8_SCHED;
            PG8_LDA(At, 0, 1); PG8_STAGE(PG8_SB(0, 0), b2, voffB); PG8_STAGE(PG8_SB(0, 1), b2 + hstep, voffB); PG8_STAGE(PG8_SA(0, 0), a2, voffA);
            PG8_WAIT_V(8); PG8_WAIT_L(0); PG8_BAR; PG8_MMA(1, 0, At, B0); PG8_MMA(1, 1, At, B1); PG8_BAR; PG8_SCHED;
            PG8_LDB(B0, 1, 0); PG8_LDB(B1, 1, 1); PG8_SCHED; PG8_LDA(At, 1, 0); PG8_STAGE(PG8_SA(0, 1), a2 + hstep, voffA);
            PG8_WAIT_V(8); PG8_WAIT_L(0); PG8_BAR; PG8_MMA(0, 0, At, B0); PG8_MMA(0, 1, At, B1); PG8_BAR; PG8_SCHED;
            PG8_LDA(At, 1, 1); PG8_STAGE(PG8_SB(1, 0), b3, voffB); PG8_STAGE(PG8_SB(1, 1), b3 + hstep, voffB); PG8_STAGE(PG8_SA(1, 0), a3, voffA);
            PG8_WAIT_V(8); PG8_WAIT_L(0); PG8_BAR; PG8_MMA(1, 0, At, B0); PG8_MMA(1, 1, At, B1); PG8_BAR; PG8_SCHED;
            } else {
            PG8_LDB(B0, 0, 0); PG8_SCHED; PG8_LDA(At, 0, 0); PG8_STAGE(PG8_SA(1, 1), a1 + hstep, voffA);
            PG8_WAIT_L(8); PG8_BAR; PG8_WAIT_L(0); PG8_MMA(0, 0, At, B0); PG8_BAR; PG8_SCHED;
            PG8_LDB(B1, 0, 1); PG8_STAGE(PG8_SB(0, 0), b2, voffB);
            PG8_BAR; PG8_WAIT_L(0); PG8_MMA(0, 1, At, B1); PG8_BAR;
            PG8_LDA(At, 0, 1); PG8_STAGE(PG8_SA(0, 0), a2, voffA);
            PG8_BAR; PG8_WAIT_L(0); PG8_MMA(1, 0, At, B0); PG8_BAR; PG8_SCHED;
            PG8_STAGE(PG8_SB(0, 1), b2 + hstep, voffB);
            PG8_WAIT_V(6); PG8_BAR; PG8_MMA(1, 1, At, B1); PG8_BAR;
            PG8_LDB(B0, 1, 0); PG8_SCHED; PG8_LDA(At, 1, 0); PG8_STAGE(PG8_SA(0, 1), a2 + hstep, voffA);
            PG8_WAIT_L(8); PG8_BAR; PG8_WAIT_L(0); PG8_MMA(0, 0, At, B0); PG8_BAR; PG8_SCHED;
            PG8_LDB(B1, 1, 1); PG8_STAGE(PG8_SB(1, 0), b3, voffB);
            PG8_BAR; PG8_WAIT_L(0); PG8_MMA(0, 1, At, B1); PG8_BAR;
            PG8_LDA(At, 1, 1); PG8_STAGE(PG8_SA(1, 0), a3, voffA);
            PG8_BAR; PG8_WAIT_L(0); PG8_MMA(1, 0, At, B0); PG8_BAR; PG8_SCHED;
            PG8_STAGE(PG8_SB(1, 1), b3 + hstep, voffB);
            PG8_WAIT_V(6); PG8_BAR; PG8_MMA(1, 1, At, B1); PG8_BAR;
            }
        }
        if constexpr (ALIGN_EPI) { if (wr == 0) PG8_BAR; }
        if constexpr (!Epi::AFTER_DRAIN) { E(acc, cur, wr, wc, fr, fq); S.done(cur); }
        if (!has_next) break;
#pragma unroll
        for (int a = 0; a < 2; ++a)
#pragma unroll
            for (int b = 0; b < 2; ++b)
#pragma unroll
                for (int m = 0; m < 4; ++m)
#pragma unroll
                    for (int n = 0; n < 2; ++n) acc[a][b][m][n] = (f32x4){0.f, 0.f, 0.f, 0.f};
        cur = nxt; cA = nA; cB = nB; ++ui;
        if constexpr (ALIGN_EPI) { if (wr == 1) PG8_BAR; }
    }
    PG8_WAIT_V(0);
    if constexpr (!ALIGN_EPI) { if (wr == 0) PG8_BAR; }
    PG8_BAR;
    if constexpr (Epi::AFTER_DRAIN) { E.fused(acc, cur, wr, wc, fr, fq, lds, wid, lane); S.done(cur); }
#undef PG8_SA
#undef PG8_SB
#undef PG8_STAGE
#undef PG8_LDA
#undef PG8_LDB
#undef PG8_MMA
#undef PG8_WAIT_V
#undef PG8_WAIT_L
#undef PG8_BAR
#undef PG8_SCHED
}
}
#define DI __device__ __forceinline__
#define LAS __attribute__((address_space(3)))
typedef unsigned short bf16;
typedef unsigned v4u __attribute__((ext_vector_type(4)));
typedef unsigned v2u __attribute__((ext_vector_type(2)));
typedef float f32x4 __attribute__((ext_vector_type(4)));

constexpr int NB = 4, LSEQ = 8192, DM = 1024, LCTX = 256, NLAT = NB * LSEQ, NCTX = NB * LCTX, MTOT = NLAT + NCTX;
constexpr int INW = 3072, DFF = 2816, DFFH = 1408;
constexpr int CA_Q = 0, CA_K = 512, CA_V = 640, CB_QF = 768, CB_FF = 1024, CB_QB = 1280, CB_FB = 1536, CB_I = 1792, CB_G = 2048, CC_Q = 2304, CC_K = 2560, CC_V = 2816;
constexpr float EPS = 1e-6f;
constexpr size_t MiB = 1u << 20;
constexpr size_t WS_SMALL = 1 * MiB, WS_WIN = 2 * MiB, WS_WOUT = 14 * MiB, WS_WUP = 18 * MiB, WS_WDN = 40 * MiB, WS_XC = 52 * MiB, WS_H = 56 * MiB, WS_MIX = 122 * MiB,
                 WS_P = 188 * MiB, WS_ST = 386 * MiB, WS_U = 188 * MiB, WS_ACT = 370 * MiB, WS_END = 462 * MiB;
constexpr int SM_MOD = 0  , SM_TAC = 65536, SM_TAS = SM_TAC + 2048, SM_TDC = SM_TAS + 2048, SM_TDS = SM_TDC + 1024, SM_LOWER = SM_TDS + 1024  , SM_LAM = SM_LOWER + 1024;
constexpr int LDS_BYTES = 147456;

DI unsigned f2bf(float f) { unsigned u = __builtin_bit_cast(unsigned, f); return (u + 0x7fffu + ((u >> 16) & 1u)) >> 16; }
DI unsigned pk2(float lo, float hi) { return f2bf(lo) | (f2bf(hi) << 16); }
DI float bf2f(bf16 u) { return __builtin_bit_cast(float, ((unsigned)u) << 16); }
DI float shx_(int lane, float v, int m) { return __builtin_bit_cast(float, __builtin_amdgcn_ds_bpermute((lane ^ m) << 2, __builtin_bit_cast(int, v))); }
DI float wave_sum(int lane, float v) {
#pragma unroll
    for (int o = 1; o < 64; o <<= 1) v += shx_(lane, v, o);
    return v;
}
DI float wave_max(int lane, float v) {
#pragma unroll
    for (int o = 1; o < 64; o <<= 1) v = fmaxf(v, shx_(lane, v, o));
    return v;
}
DI float silu_f(float x) { return x / (1.f + __expf(-x)); }
DI float sigmoid_f(float x) { return 1.f / (1.f + __expf(-x)); }

struct Args { const float* in[23]; float* out; unsigned char* ws; };
struct Ctx {
    const float *x, *c, *ctx, *c_ctx, *w_mod, *b_mod, *n1g, *n2g, *w_in, *wqg, *wkg, *wsink, *hglow, *hgog, *dqg, *dkg, *dlam, *dog, *w_out, *w_up, *conv_w, *conv_b, *w_down;
    float* out; unsigned char* ws;
    float* SM; bf16 *Win_t, *Wout_t, *Wup_t, *Wdn_t, *H, *MIX, *P, *U, *ACT; float *XC, *ST;
    int lane, wave, tid, gw, NGW;
};


DI int fresh_lane() { int l_; asm volatile("v_mbcnt_lo_u32_b32 %0, -1, 0\n\tv_mbcnt_hi_u32_b32 %0, -1, %0" : "=v"(l_)); return l_; }
DI Ctx make_ctx(const Args& args, int wave_s) {
    Ctx C;
    C.x = args.in[0]; C.c = args.in[1]; C.ctx = args.in[2]; C.c_ctx = args.in[3]; C.w_mod = args.in[4]; C.b_mod = args.in[5]; C.n1g = args.in[6]; C.n2g = args.in[7];
    C.w_in = args.in[8]; C.wqg = args.in[9]; C.wkg = args.in[10]; C.wsink = args.in[11]; C.hglow = args.in[12]; C.hgog = args.in[13]; C.dqg = args.in[14]; C.dkg = args.in[15];
    C.dlam = args.in[16]; C.dog = args.in[17]; C.w_out = args.in[18]; C.w_up = args.in[19]; C.conv_w = args.in[20]; C.conv_b = args.in[21]; C.w_down = args.in[22];
    C.out = args.out; C.ws = args.ws;
    C.SM = (float*)(args.ws + WS_SMALL); C.Win_t = (bf16*)(args.ws + WS_WIN); C.Wout_t = (bf16*)(args.ws + WS_WOUT); C.Wup_t = (bf16*)(args.ws + WS_WUP); C.Wdn_t = (bf16*)(args.ws + WS_WDN);
    C.XC = (float*)(args.ws + WS_XC); C.H = (bf16*)(args.ws + WS_H); C.MIX = (bf16*)(args.ws + WS_MIX); C.P = (bf16*)(args.ws + WS_P); C.ST = (float*)(args.ws + WS_ST);
    C.U = (bf16*)(args.ws + WS_U); C.ACT = (bf16*)(args.ws + WS_ACT);
    C.lane = fresh_lane(); C.wave = wave_s; C.tid = wave_s * 64 + C.lane; C.gw = blockIdx.x * 8 + C.wave; C.NGW = gridDim.x * 8;
    return C;
}

DI void p0_transpose_item(const float* W, int N, int k0, int n0, bf16* dst, int dst_ld, LAS float* scr, int lane) {
    f32x4 v[8];
#pragma unroll
    for (int i = 0; i < 8; ++i) v[i] = __builtin_nontemporal_load((const f32x4*)(W + (size_t)(k0 + 8 * i + (lane >> 3)) * N + n0 + 4 * (lane & 7)));
#pragma unroll
    for (int i = 0; i < 8; ++i) { LAS float* q = scr + (8 * i + (lane >> 3)) * 33 + 4 * (lane & 7); q[0] = v[i].x; q[1] = v[i].y; q[2] = v[i].z; q[3] = v[i].w; }
    asm volatile("s_waitcnt lgkmcnt(0)" ::: "memory");
    const int c = lane & 7;
#pragma unroll
    for (int j = 0; j < 4; ++j) { const int n = (lane >> 3) + 8 * j; const LAS float* s = scr + (8 * c) * 33 + n;
        v4u o; o.x = pk2(s[0 * 33], s[1 * 33]); o.y = pk2(s[2 * 33], s[3 * 33]); o.z = pk2(s[4 * 33], s[5 * 33]); o.w = pk2(s[6 * 33], s[7 * 33]);
        *(v4u*)(dst + (size_t)n * dst_ld + 8 * c) = o; }
    asm volatile("s_waitcnt lgkmcnt(0)" ::: "memory");
}
DI int permup(int n) { const int a = n >= DFF ? 1 : 0; const int ch = n - a * DFF; return (ch >> 7) * 256 + a * 128 + (ch & 127); }

DI void p0_phase(const Args& A, int wave_s, LAS unsigned char* lds) {
    const Ctx C = make_ctx(A, wave_s);
    {
        LAS float* sv = (LAS float*)lds;
        LAS float* red = (LAS float*)(lds + 32768);
        for (int unit = blockIdx.x; unit < 192; unit += gridDim.x) {
            const int l = unit / 96, c0 = (unit % 96) * 64;
            __syncthreads();
            for (int e = C.tid; e < 5120; e += 512) { const int v = e >> 10, k = e & 1023; const float xv = v < 4 ? C.c[v * 1024 + k] : C.c_ctx[k]; sv[e] = silu_f(xv); }
            __syncthreads();
            const float* W = C.w_mod + (size_t)l * 1024 * 6144 + c0 + C.lane;
            float a0 = 0.f, a1 = 0.f, a2 = 0.f, a3 = 0.f, a4 = 0.f;
            const int kb = C.wave * 128;
#pragma unroll 16
            for (int k = 0; k < 128; ++k) { const float w = __builtin_nontemporal_load(W + (size_t)(kb + k) * 6144);
                a0 += sv[kb + k] * w; a1 += sv[1024 + kb + k] * w; a2 += sv[2048 + kb + k] * w; a3 += sv[3072 + kb + k] * w; a4 += sv[4096 + kb + k] * w; }
            red[(C.wave * 5 + 0) * 64 + C.lane] = a0; red[(C.wave * 5 + 1) * 64 + C.lane] = a1; red[(C.wave * 5 + 2) * 64 + C.lane] = a2;
            red[(C.wave * 5 + 3) * 64 + C.lane] = a3; red[(C.wave * 5 + 4) * 64 + C.lane] = a4;
            __syncthreads();
            if (C.tid < 320) { const int v = C.tid >> 6, cc = C.tid & 63; float s = 0.f;
#pragma unroll
                for (int w = 0; w < 8; ++w) s += red[(w * 5 + v) * 64 + cc];
                C.SM[SM_MOD + (l * 5 + v) * 6144 + c0 + cc] = s + C.b_mod[l * 6144 + c0 + cc]; }
        }
        __syncthreads();
    }
    if (blockIdx.x == gridDim.x - 1) {
        for (int e = C.tid; e < 2048; e += 512) { const int p = e >> 4, i = e & 15;
            const float inv = exp2f((float)(-(double)i / 16.0 * 13.287712379549449)); const float ang = (float)p * inv;
            const double ad = (double)ang * 0.15915494309189535; const double kk = __builtin_rint(ad); const float rev = (float)(ad - kk);
            C.SM[SM_TAC + e] = __builtin_amdgcn_cosf(rev); C.SM[SM_TAS + e] = __builtin_amdgcn_sinf(rev); }
        for (int e = C.tid; e < 1024; e += 512) { const int p = e >> 3, i = e & 7;
            const float inv = exp2f((float)(-(double)i / 8.0 * 13.287712379549449)); const float ang = (float)p * inv;
            const double ad = (double)ang * 0.15915494309189535; const double kk = __builtin_rint(ad); const float rev = (float)(ad - kk);
            C.SM[SM_TDC + e] = __builtin_amdgcn_cosf(rev); C.SM[SM_TDS + e] = __builtin_amdgcn_sinf(rev); }
        for (int e = C.tid; e < 512; e += 512) { C.SM[SM_LOWER + e] = 0.f; C.SM[SM_LOWER + 512 + e] = 1.f / (1.f + __expf(C.hglow[e] - C.hglow[512 + e])); }
        if (C.wave == 0) {
            for (int l = 0; l < 2; ++l) { const float* L = C.dlam + l * 128;
                float a = C.lane < 32 ? L[C.lane] * L[32 + C.lane] : 0.f, b = C.lane < 32 ? L[64 + C.lane] * L[96 + C.lane] : 0.f;
                a = wave_sum(C.lane, a); b = wave_sum(C.lane, b);
                const float lam_init = 0.8f - 0.6f * __expf(-0.3f * (float)l);
                if (C.lane == 0) C.SM[SM_LAM + l] = __expf(a) - __expf(b) + lam_init; }
        }
    }
}
DI void p0_transposes(const Args& A, int wave_s, LAS unsigned char* lds, int it_lo, int it_hi, int widx, int nworkers) {
    const Ctx C = make_ctx(A, wave_s);
    LAS float* scr = (LAS float*)(lds + 49152 + C.wave * 8704);
    constexpr int I_IN = 16 * 96, I_OUT = 16 * 32, I_UP = 16 * 176, I_DN = 44 * 32, I_L = I_IN + I_OUT + I_UP + I_DN;
    for (int it = it_lo + widx; it < it_hi; it += nworkers) {
        const int l = it / I_L; int r = it % I_L;
        if (r < I_IN) { const int kb = r / 96, nb = r % 96; p0_transpose_item(C.w_in + (size_t)l * 1024 * 3072, 3072, 64 * kb, 32 * nb, C.Win_t + (size_t)l * 3072 * 1024 + (size_t)(32 * nb) * 1024 + 64 * kb, 1024, scr, C.lane); continue; } r -= I_IN;
        if (r < I_OUT) { const int kb = r / 32, nb = r % 32; p0_transpose_item(C.w_out + (size_t)l * 1024 * 1024, 1024, 64 * kb, 32 * nb, C.Wout_t + (size_t)l * 1024 * 1024 + (size_t)(32 * nb) * 1024 + 64 * kb, 1024, scr, C.lane); continue; } r -= I_OUT;
        if (r < I_UP) { const int kb = r / 176, nb = r % 176; p0_transpose_item(C.w_up + (size_t)l * 1024 * 5632, 5632, 64 * kb, 32 * nb, C.Wup_t + (size_t)l * 5632 * 1024 + (size_t)permup(32 * nb) * 1024 + 64 * kb, 1024, scr, C.lane); continue; } r -= I_UP;
        { const int kb = r / 32, nb = r % 32; const int k0 = 64 * kb;
          p0_transpose_item(C.w_down + (size_t)l * 2816 * 1024, 1024, k0, 32 * nb, C.Wdn_t + (size_t)l * 2816 * 1024 + (size_t)(32 * nb) * DFF + k0, DFF, scr, C.lane); }
    }
}

DI void norm_phase(const Args& A, int wave_s, int l, int which, int rows) {
    const Ctx C = make_ctx(A, wave_s);
    const float* gn = (which == 1 ? C.n1g : C.n2g) + l * 1024;
    const bool from_in = (l == 0 && which == 1);
    f32x4 g[4];
#pragma unroll
    for (int j = 0; j < 4; ++j) g[j] = *(const f32x4*)(gn + 4 * (C.lane + 64 * j));
    for (int m0 = C.gw * 2; m0 < rows; m0 += C.NGW * 2) {
        f32x4 xv[2][4];
        const float* modp[2];
#pragma unroll
        for (int rr = 0; rr < 2; ++rr) {
            const int m = m0 + rr; const float* xr; int v;
            if (m < NLAT) { xr = (from_in ? C.x : C.out) + (size_t)m * 1024; v = m >> 13; }
            else { xr = (from_in ? C.ctx : C.XC) + (size_t)(m - NLAT) * 1024; v = 4; }
            modp[rr] = C.SM + SM_MOD + (l * 5 + v) * 6144 + (which == 1 ? 0 : 3072);
#pragma unroll
            for (int j = 0; j < 4; ++j) xv[rr][j] = ((const f32x4*)xr)[C.lane + 64 * j];
        }
#pragma unroll
        for (int rr = 0; rr < 2; ++rr) {
            const int m = m0 + rr;
            f32x4 sh[4], sc[4];
#pragma unroll
            for (int j = 0; j < 4; ++j) { const int col = 4 * (C.lane + 64 * j); sh[j] = *(const f32x4*)(modp[rr] + col); sc[j] = *(const f32x4*)(modp[rr] + 1024 + col); }
            float ss = 0.f;
#pragma unroll
            for (int j = 0; j < 4; ++j) ss += (xv[rr][j].x * xv[rr][j].x + xv[rr][j].y * xv[rr][j].y) + (xv[rr][j].z * xv[rr][j].z + xv[rr][j].w * xv[rr][j].w);
            ss = wave_sum(C.lane, ss);
            const float rs = rsqrtf(ss * (1.f / 1024.f) + EPS);
#pragma unroll
            for (int j = 0; j < 4; ++j) { const int col = 4 * (C.lane + 64 * j);
                const f32x4 y = xv[rr][j] * rs * g[j] * (sc[j] + 1.f) + sh[j];
                v2u o; o.x = pk2(y.x, y.y); o.y = pk2(y.z, y.w);
                *(v2u*)(C.H + (size_t)m * 1024 + col) = o; }
        }
    }
}

DI void unpack8(const v4u w, float (&x)[8]) {
#pragma unroll
    for (int q = 0; q < 4; ++q) { x[2 * q] = __builtin_bit_cast(float, w[q] << 16); x[2 * q + 1] = __builtin_bit_cast(float, w[q] & 0xffff0000u); }
}
DI void prep_phase(const Args& A, int wave_s, int l) {
    const Ctx C = make_ctx(A, wave_s);
    const int L = C.lane, jA = L & 7, jD = L & 3;
    float gqA[8], gkA[8], gD[8];
#pragma unroll
    for (int e = 0; e < 8; ++e) { gqA[e] = C.wqg[l * 64 + 8 * jA + e] * (0.125f * 1.4426950408889634f); gkA[e] = C.wkg[l * 64 + 8 * jA + e];
        gD[e] = (L < 32) ? C.dqg[l * 32 + 8 * jD + e] * (0.17677669529663687f * 1.4426950408889634f) : C.dkg[l * 32 + 8 * jD + e]; }
    const float* TAC = C.SM + SM_TAC; const float* TAS = C.SM + SM_TAS; const float* TDC = C.SM + SM_TDC; const float* TDS = C.SM + SM_TDS;
    for (int m = C.gw; m < MTOT; m += C.NGW) {
        bf16* pr = C.P + (size_t)m * INW;
        const bool latent = m < NLAT; const int t = m & 8191, rpos = t >> 6, cpos = t & 63;
        const v4u wq = *(const v4u*)(pr + 8 * L), wk = (L < 16) ? *(const v4u*)(pr + 512 + 8 * L) : (v4u){0u, 0u, 0u, 0u}, wd = *(const v4u*)(pr + CC_Q + 8 * L);
        float cA[8], sA[8], cD[8], sD[8];
        if (latent) { const int posA = (jA < 4) ? rpos : cpos, iA = 8 * (jA & 1); const int posD = (jD < 2) ? rpos : cpos;
#pragma unroll
            for (int e = 0; e < 8; ++e) { cA[e] = TAC[posA * 16 + iA + e]; sA[e] = TAS[posA * 16 + iA + e]; cD[e] = TDC[posD * 8 + e]; sD[e] = TDS[posD * 8 + e]; }
        } else {
#pragma unroll
            for (int e = 0; e < 8; ++e) { cA[e] = 1.f; sA[e] = 0.f; cD[e] = 1.f; sD[e] = 0.f; }
        }
#pragma unroll
        for (int part = 0; part < 2; ++part) {
            float x[8]; unpack8(part ? wk : wq, x);
            float ss = 0.f;
#pragma unroll
            for (int e = 0; e < 8; ++e) ss += x[e] * x[e];
            ss += shx_(L, ss, 1); ss += shx_(L, ss, 2); ss += shx_(L, ss, 4);
            const float rs = rsqrtf(ss * (1.f / 64.f) + EPS);
            float y[8], y2[8];
#pragma unroll
            for (int e = 0; e < 8; ++e) y[e] = x[e] * rs * (part ? gkA[e] : gqA[e]);
#pragma unroll
            for (int e = 0; e < 8; ++e) y2[e] = shx_(L, y[e], 2);
            unsigned o[4];
#pragma unroll
            for (int q = 0; q < 4; ++q) { float r0, r1;
                { const int e = 2 * q; r0 = (jA & 2) ? (y2[e] * sA[e] + y[e] * cA[e]) : (y[e] * cA[e] - y2[e] * sA[e]); }
                { const int e = 2 * q + 1; r1 = (jA & 2) ? (y2[e] * sA[e] + y[e] * cA[e]) : (y[e] * cA[e] - y2[e] * sA[e]); }
                o[q] = pk2(r0, r1); }
            const v4u ov = {o[0], o[1], o[2], o[3]};
            if (part == 0) *(v4u*)(pr + 8 * L) = ov; else if (L < 16) *(v4u*)(pr + 512 + 8 * L) = ov;
        }
        {
            float x[8]; unpack8(wd, x);
            float ss = 0.f;
#pragma unroll
            for (int e = 0; e < 8; ++e) ss += x[e] * x[e];
            ss += shx_(L, ss, 1); ss += shx_(L, ss, 2);
            const float rs = rsqrtf(ss * (1.f / 32.f) + EPS);
            float y[8], y2[8];
#pragma unroll
            for (int e = 0; e < 8; ++e) y[e] = x[e] * rs * gD[e];
#pragma unroll
            for (int e = 0; e < 8; ++e) y2[e] = shx_(L, y[e], 1);
            unsigned o[4];
#pragma unroll
            for (int q = 0; q < 4; ++q) { float r0, r1;
                { const int e = 2 * q; r0 = (jD & 1) ? (y2[e] * sD[e] + y[e] * cD[e]) : (y[e] * cD[e] - y2[e] * sD[e]); }
                { const int e = 2 * q + 1; r1 = (jD & 1) ? (y2[e] * sD[e] + y[e] * cD[e]) : (y[e] * cD[e] - y2[e] * sD[e]); }
                o[q] = pk2(r0, r1); }
            *(v4u*)(pr + CC_Q + 8 * L) = (v4u){o[0], o[1], o[2], o[3]};
        }
    }
}

DI void hgrn_naive(const Args& A, int wave_s, int l, bool need_ctx) {
    const Ctx C = make_ctx(A, wave_s);
    const float og = C.hgog[l * 64 + C.lane];
    for (int task = C.gw; task < 16; task += C.NGW) {
        const int b = task >> 2, h = task & 3;
        for (int dir = 0; dir < 2; ++dir) {
            const float lbv = C.SM[SM_LOWER + (l * 2 + dir) * 256 + h * 64 + C.lane];
            float S[64];
#pragma unroll
            for (int k = 0; k < 64; ++k) S[k] = 0.f;
            const int qcol = (dir ? CB_QB : CB_QF) + h * 64 + C.lane, fcol = (dir ? CB_FB : CB_FF) + h * 64 + C.lane;
            for (int step = 0; step < LCTX + LSEQ; ++step) {
                int r;
                if (step < LCTX) { const int tc = dir ? (LCTX - 1 - step) : step; r = NLAT + b * LCTX + tc; }
                else { const int t0 = step - LCTX; const int t = dir ? (LSEQ - 1 - t0) : t0; r = b * LSEQ + t; }
                const bf16* pr = C.P + (size_t)r * INW;
                const float qv = bf2f(pr[qcol]), pf = bf2f(pr[fcol]), iv = bf2f(pr[CB_I + h * 64 + C.lane]);
                const float f = lbv + (1.f - lbv) * sigmoid_f(pf), kk = 1.f - f;
                float o = 0.f;
#pragma unroll
                for (int k = 0; k < 64; ++k) {
                    const float fk = __builtin_bit_cast(float, __builtin_amdgcn_readlane(__builtin_bit_cast(int, f), k));
                    const float kx = __builtin_bit_cast(float, __builtin_amdgcn_readlane(__builtin_bit_cast(int, kk), k));
                    const float qk = __builtin_bit_cast(float, __builtin_amdgcn_readlane(__builtin_bit_cast(int, qv), k));
                    S[k] = fk * S[k] + kx * iv; o += S[k] * qk;
                }
                float* op = C.ST + (size_t)r * 256 + h * 64 + C.lane;
                if (dir == 0) { *op = o; }
                else if (r < NLAT || need_ctx) {
                    const float tot = *op + o; const float ss = wave_sum(C.lane, tot * tot);
                    const float g = bf2f(pr[CB_G + h * 64 + C.lane]);
                    const float y = tot * rsqrtf(ss * (1.f / 64.f) + EPS) * og * silu_f(g);
                    C.MIX[(size_t)r * 1024 + 512 + h * 64 + C.lane] = (bf16)f2bf(y);
                }
            }
        }
    }
}

DI void win_naive(const Args& A, int wave_s, int l, bool need_ctx) {
    const Ctx C = make_ctx(A, wave_s);
    const float Mb = 8.f * 1.4426950408889634f * wave_max(C.lane, fabsf(C.wqg[l * 64 + C.lane])) * wave_max(C.lane, fabsf(C.wkg[l * 64 + C.lane]));
    const int ntask = (need_ctx ? MTOT : NLAT) * 8;
    for (int task = C.gw; task < ntask; task += C.NGW) {
        const int m = task >> 3, h = task & 7, kv = h >> 2;
        const float qx = bf2f(C.P[(size_t)m * INW + CA_Q + h * 64 + C.lane]);
        float lsum = 0.f, acc = 0.f;
        int b;
        if (m < NLAT) {
            b = m >> 13; const int t = m & 8191; const int lo = t - 128 < 0 ? 0 : t - 128, hi = t + 128 > LSEQ - 1 ? LSEQ - 1 : t + 128;
            for (int kt = lo; kt <= hi; ++kt) { const bf16* kr = C.P + (size_t)(b * LSEQ + kt) * INW;
                const float s = wave_sum(C.lane, qx * bf2f(kr[CA_K + kv * 64 + C.lane])); const float e = __builtin_amdgcn_exp2f(s - Mb);
                lsum += e; acc += e * bf2f(kr[CA_V + kv * 64 + C.lane]); }
        } else b = (m - NLAT) >> 8;
        for (int kc = 0; kc < LCTX; ++kc) { const bf16* kr = C.P + (size_t)(NLAT + b * LCTX + kc) * INW;
            const float s = wave_sum(C.lane, qx * bf2f(kr[CA_K + kv * 64 + C.lane])); const float e = __builtin_amdgcn_exp2f(s - Mb);
            lsum += e; acc += e * bf2f(kr[CA_V + kv * 64 + C.lane]); }
        const float o = acc / (lsum + __builtin_amdgcn_exp2f(C.wsink[l * 8 + h] * 1.4426950408889634f - Mb));
        C.MIX[(size_t)m * 1024 + h * 64 + C.lane] = (bf16)f2bf(o);
    }
}

DI void diff_naive(const Args& A, int wave_s, int l, bool need_ctx) {
    const Ctx C = make_ctx(A, wave_s);
    const float Mb = 5.656854249f * wave_max(C.lane, fabsf(C.dqg[l * 32 + (C.lane & 31)])) * wave_max(C.lane, fabsf(C.dkg[l * 32 + (C.lane & 31)]));
    const float lam = C.SM[SM_LAM + l]; const float lam_init = 0.8f - 0.6f * __expf(-0.3f * (float)l);
    const float og = C.dog[l * 64 + C.lane];
    const int ntask = (need_ctx ? MTOT : NLAT) * 4;
    for (int task = C.gw; task < ntask; task += C.NGW) {
        const int m = task >> 2, h = task & 3;
        const float qx = bf2f(C.P[(size_t)m * INW + CC_Q + h * 64 + C.lane]);
        float l0 = 0.f, l1 = 0.f, a0 = 0.f, a1 = 0.f;
        const bool latent = m < NLAT; const int b = latent ? (m >> 13) : ((m - NLAT) >> 8);
        const int nk = latent ? LSEQ + LCTX : LCTX;
        for (int j = 0; j < nk; ++j) {
            const int r = latent ? (j < LSEQ ? b * LSEQ + j : NLAT + b * LCTX + (j - LSEQ)) : NLAT + b * LCTX + j;
            const bf16* kr = C.P + (size_t)r * INW;
            float pr = qx * bf2f(kr[CC_K + h * 64 + C.lane]);
#pragma unroll
            for (int o = 1; o < 32; o <<= 1) pr += shx_(C.lane, pr, o);
            const float po = shx_(C.lane, pr, 32);
            const float s0 = (C.lane < 32 ? pr : po) * 0.17677669529663687f, s1 = (C.lane < 32 ? po : pr) * 0.17677669529663687f;
            const float e0 = __expf(s0 - Mb), e1 = __expf(s1 - Mb);
            const float vv = bf2f(kr[CC_V + h * 64 + C.lane]);
            l0 += e0; l1 += e1; a0 += e0 * vv; a1 += e1 * vv;
        }
        const float o = a0 / l0 - lam * (a1 / l1);
        const float ss = wave_sum(C.lane, o * o);
        const float y = o * rsqrtf(ss * (1.f / 64.f) + EPS) * og * (1.f - lam_init);
        C.MIX[(size_t)m * 1024 + 768 + h * 64 + C.lane] = (bf16)f2bf(y);
    }
}


typedef short bf16x8 __attribute__((ext_vector_type(8)));
typedef short s16x4 __attribute__((ext_vector_type(4)));
typedef float f32x16 __attribute__((ext_vector_type(16)));
typedef __bf16 bfv2 __attribute__((ext_vector_type(2)));
typedef float fv2 __attribute__((ext_vector_type(2)));
DI unsigned pkbf(float a, float b) { fv2 v = {a, b}; return __builtin_bit_cast(unsigned, __builtin_convertvector(v, bfv2)); }
#define MFMA32(a, b, c) __builtin_amdgcn_mfma_f32_32x32x16_bf16((a), (b), (c), 0, 0, 0)
#define PACK8(x, s) __builtin_bit_cast(bf16x8, (v4u){pkbf((x)[8 * (s)], (x)[8 * (s) + 1]), pkbf((x)[8 * (s) + 2], (x)[8 * (s) + 3]), pkbf((x)[8 * (s) + 4], (x)[8 * (s) + 5]), pkbf((x)[8 * (s) + 6], (x)[8 * (s) + 7])})
DI bf16x8 tr_pair(LAS unsigned char* p) {
    const s16x4 lo = __builtin_amdgcn_ds_read_tr16_b64_v4i16((LAS s16x4*)p), hi = __builtin_amdgcn_ds_read_tr16_b64_v4i16((LAS s16x4*)(p + 8 * 144));
    return __builtin_shufflevector(lo, hi, 0, 1, 2, 3, 4, 5, 6, 7);
}
constexpr int KV_PITCH = 144, KV_IMG = 64 * KV_PITCH;
constexpr int VP = 192;
DI bf16x8 tr_pairV(LAS unsigned char* p) {
    const s16x4 lo = __builtin_amdgcn_ds_read_tr16_b64_v4i16((LAS s16x4*)p), hi = __builtin_amdgcn_ds_read_tr16_b64_v4i16((LAS s16x4*)(p + 8 * VP));
    return __builtin_shufflevector(lo, hi, 0, 1, 2, 3, 4, 5, 6, 7);
}

constexpr int DT_ROWS = 128, DT_IMG = DT_ROWS * KV_PITCH;
DI void diff_mfma_phase(const Args& A, int wave_s, int l, bool need_ctx, LAS unsigned char* lds) {
    const Ctx C = make_ctx(A, wave_s);
    const int lane = C.lane, wave = C.wave, r = lane & 31, h = lane >> 5;
    const float Mb2 = 5.656854249f * 1.4426950408889634f * wave_max(C.lane, fabsf(C.dqg[l * 32 + (lane & 31)])) * wave_max(C.lane, fabsf(C.dkg[l * 32 + (lane & 31)]));
    const float lam = C.SM[SM_LAM + l]; const float lam_init = 0.8f - 0.6f * __expf(-0.3f * (float)l);
    const int nunits = 512 + (need_ctx ? 16 : 0);
    const int srow = C.tid >> 3, sch = C.tid & 7;
    const unsigned sgoff = (unsigned)(srow * INW + sch * 8) * 2u;
    const int q4 = (lane & 15) >> 2, p4 = lane & 3, grp = (lane >> 4) & 1;
    const int voff = (4 * h + q4) * VP + (16 * grp + 4 * p4) * 2;
    constexpr int DV_IMG = DT_ROWS * VP, VOFF0 = 2 * DT_IMG;
    f32x16 negM;
#pragma unroll
    for (int i = 0; i < 16; ++i) negM[i] = 0.f;
    (void)Mb2;
    for (int u = blockIdx.x; u < nunits; u += gridDim.x) {
        int b, hd, qrow0, ntiles;
        if (u < 512) { b = u >> 7; hd = (u >> 5) & 3; qrow0 = b * LSEQ + (u & 31) * 256; ntiles = 66; }
        else { const int uu = u - 512; b = uu >> 2; hd = uu & 3; qrow0 = NLAT + b * LCTX; ntiles = 2; }
        const int kbase0 = (u < 512) ? b * LSEQ : NLAT + b * LCTX, kbase1 = NLAT + b * LCTX - 64 * DT_ROWS;
        const bf16* qp = C.P + (size_t)qrow0 * INW + CC_Q + hd * 64 + (unsigned)((wave * 32 + r) * INW);
        bf16x8 Qf[2][2];
#pragma unroll
        for (int c = 0; c < 2; ++c)
#pragma unroll
            for (int s = 0; s < 2; ++s) Qf[c][s] = *(const bf16x8*)(qp + c * 32 + s * 16 + h * 8);
        f32x16 O[2][2];
#pragma unroll
        for (int c = 0; c < 2; ++c)
#pragma unroll
            for (int mt = 0; mt < 2; ++mt)
#pragma unroll
                for (int i = 0; i < 16; ++i) O[c][mt][i] = 0.f;
        float ls0 = 0.f, ls1 = 0.f;
        bf16x8 Pp0 = {0, 0, 0, 0, 0, 0, 0, 0}, Pp1 = {0, 0, 0, 0, 0, 0, 0, 0};
        bf16x8 Vs[4];
#pragma unroll
        for (int b_ = 0; b_ < 4; ++b_) Vs[b_] = (bf16x8){0, 0, 0, 0, 0, 0, 0, 0};
        v4u kreg[2], vreg[2];
        { const char* kb_ = (const char*)(C.P + (size_t)kbase0 * INW + CC_K + hd * 64); const char* vb_ = (const char*)(C.P + (size_t)kbase0 * INW + CC_V + hd * 64);
          kreg[0] = *(const v4u*)(kb_ + sgoff); vreg[0] = *(const v4u*)(vb_ + sgoff);
          kreg[1] = *(const v4u*)(kb_ + (size_t)64 * INW * 2 + sgoff); vreg[1] = *(const v4u*)(vb_ + (size_t)64 * INW * 2 + sgoff); }
        __syncthreads();
        *(LAS v4u*)(lds + srow * KV_PITCH + sch * 16) = kreg[0]; *(LAS v4u*)(lds + (srow + 64) * KV_PITCH + sch * 16) = kreg[1];
        *(LAS v4u*)(lds + VOFF0 + srow * VP + sch * 16) = vreg[0]; *(LAS v4u*)(lds + VOFF0 + (srow + 64) * VP + sch * 16) = vreg[1];
        __syncthreads();
        for (int it = 0; it < ntiles; ++it) {
            const int cur = it & 1;
            if (it + 1 < ntiles) { const int kr0 = (it + 1 < 64 ? kbase0 : kbase1) + (it + 1) * DT_ROWS;
                const char* kb_ = (const char*)(C.P + (size_t)kr0 * INW + CC_K + hd * 64);
                kreg[0] = *(const v4u*)(kb_ + sgoff); kreg[1] = *(const v4u*)(kb_ + (size_t)64 * INW * 2 + sgoff); }
            LAS unsigned char* Kb = lds + cur * DT_IMG; LAS unsigned char* Vb = lds + VOFF0 + cur * DV_IMG;
            LAS unsigned char* kl = Kb + r * KV_PITCH + h * 16;
            f32x16 Sc;
            { const bf16x8 kA0 = *(LAS bf16x8*)(kl), kA1 = *(LAS bf16x8*)(kl + 32); Sc = MFMA32(kA0, Qf[0][0], negM); Sc = MFMA32(kA1, Qf[0][1], Sc); }
#pragma unroll
            for (int g = 0; g < 8; ++g) {
                const int c = g & 1, sub = g >> 1;
                bf16x8 kB0, kB1; f32x16 Sn;
                if (g < 7) { LAS unsigned char* kp = kl + (32 * ((g + 1) >> 1)) * KV_PITCH + (c ^ 1) * 64; kB0 = *(LAS bf16x8*)(kp); kB1 = *(LAS bf16x8*)(kp + 32); }
                if (c == 0) { O[1][0] = MFMA32(Vs[0], Pp0, O[1][0]); O[1][1] = MFMA32(Vs[2], Pp0, O[1][1]); O[1][0] = MFMA32(Vs[1], Pp1, O[1][0]); O[1][1] = MFMA32(Vs[3], Pp1, O[1][1]); }
                else        { O[0][0] = MFMA32(Vs[0], Pp0, O[0][0]); O[0][1] = MFMA32(Vs[2], Pp0, O[0][1]); O[0][0] = MFMA32(Vs[1], Pp1, O[0][0]); O[0][1] = MFMA32(Vs[3], Pp1, O[0][1]); }
                float t = 0.f;
#pragma unroll
                for (int i = 0; i < 8; ++i) { Sc[i] = __builtin_amdgcn_exp2f(Sc[i]); t += Sc[i]; }
                const bf16x8 Pn0 = PACK8(Sc, 0);
                __builtin_amdgcn_sched_barrier(0);
                if (g < 7) { Sn = MFMA32(kB0, Qf[c ^ 1][0], negM); Sn = MFMA32(kB1, Qf[c ^ 1][1], Sn); }
                __builtin_amdgcn_sched_barrier(0);
                if (c == 0) { LAS unsigned char* vp = Vb + (32 * sub) * VP + voff; Vs[0] = tr_pairV(vp); Vs[1] = tr_pairV(vp + 16 * VP); Vs[2] = tr_pairV(vp + 64); Vs[3] = tr_pairV(vp + 16 * VP + 64); }
#pragma unroll
                for (int i = 8; i < 16; ++i) { Sc[i] = __builtin_amdgcn_exp2f(Sc[i]); t += Sc[i]; }
                if (c == 0) ls0 += t; else ls1 += t;
                Pp0 = Pn0; Pp1 = PACK8(Sc, 1);
                if (g < 7) Sc = Sn;
                __builtin_amdgcn_sched_barrier(0);
                if (g == 3 && it + 1 < ntiles) {
                    LAS unsigned char* kb2 = lds + (cur ^ 1) * DT_IMG;
                    *(LAS v4u*)(kb2 + srow * KV_PITCH + sch * 16) = kreg[0]; *(LAS v4u*)(kb2 + (srow + 64) * KV_PITCH + sch * 16) = kreg[1];
                    const int kr0 = (it + 1 < 64 ? kbase0 : kbase1) + (it + 1) * DT_ROWS;
                    const char* vb_ = (const char*)(C.P + (size_t)kr0 * INW + CC_V + hd * 64);
                    kreg[0] = *(const v4u*)(vb_ + sgoff); kreg[1] = *(const v4u*)(vb_ + (size_t)64 * INW * 2 + sgoff);
                    __builtin_amdgcn_sched_barrier(0);
                }
            }
            if (it + 1 < ntiles) { LAS unsigned char* vb2 = lds + VOFF0 + (cur ^ 1) * DV_IMG;
                *(LAS v4u*)(vb2 + srow * VP + sch * 16) = kreg[0]; *(LAS v4u*)(vb2 + (srow + 64) * VP + sch * 16) = kreg[1]; }
            __syncthreads();
        }
        O[1][0] = MFMA32(Vs[0], Pp0, O[1][0]); O[1][1] = MFMA32(Vs[2], Pp0, O[1][1]); O[1][0] = MFMA32(Vs[1], Pp1, O[1][0]); O[1][1] = MFMA32(Vs[3], Pp1, O[1][1]);
        ls0 += shx_(C.lane, ls0, 32); ls1 += shx_(C.lane, ls1, 32);
        const float inv0 = 1.f / ls0, inv1 = lam / ls1;
        float ss = 0.f;
#pragma unroll
        for (int mt = 0; mt < 2; ++mt)
#pragma unroll
            for (int i = 0; i < 16; ++i) { const float o = O[0][mt][i] * inv0 - O[1][mt][i] * inv1; O[0][mt][i] = o; ss += o * o; }
        ss += shx_(C.lane, ss, 32);
        const float rs = rsqrtf(ss * (1.f / 64.f) + EPS) * (1.f - lam_init);
        bf16* op = C.MIX + (size_t)qrow0 * 1024 + 768 + hd * 64 + (unsigned)((wave * 32 + r) * 1024);
#pragma unroll
        for (int mt = 0; mt < 2; ++mt)
#pragma unroll
            for (int g = 0; g < 4; ++g) { const int dv0 = 32 * mt + 8 * g + 4 * h; const f32x4 og = *(const f32x4*)(C.dog + l * 64 + dv0);
                v2u w; w.x = pkbf(O[0][mt][4 * g] * rs * og.x, O[0][mt][4 * g + 1] * rs * og.y); w.y = pkbf(O[0][mt][4 * g + 2] * rs * og.z, O[0][mt][4 * g + 3] * rs * og.w);
                *(v2u*)(op + dv0) = w; }
    }
}

DI void win_mfma_phase(const Args& A, int wave_s, int l, bool need_ctx, LAS unsigned char* lds) {
    const Ctx C = make_ctx(A, wave_s);
    const int lane = C.lane, wave = C.wave, r = lane & 31, h = lane >> 5;
    const float Mb2 = 8.f * 1.4426950408889634f * wave_max(C.lane, fabsf(C.wqg[l * 64 + lane])) * wave_max(C.lane, fabsf(C.wkg[l * 64 + lane]));
    const int nunits = 1024 + (need_ctx ? 32 : 0);
    const int srow = C.tid >> 3, sch = C.tid & 7;
    const int q4 = (lane & 15) >> 2, p4 = lane & 3, grp = (lane >> 4) & 1;
    const int voff = (4 * h + q4) * KV_PITCH + (16 * grp + 4 * p4) * 2;
    const int g = wave >> 1, qh = wave & 1;
    for (int u = blockIdx.x; u < nunits; u += gridDim.x) {
        int b, kv, qrow0, t0, ntiles, tfirst;
        bool lat;
        if (u < 1024) { lat = true; b = u >> 8; kv = (u >> 7) & 1; t0 = (u & 127) * 64; qrow0 = b * LSEQ + t0; }
        else { lat = false; const int uu = u - 1024; b = uu >> 3; kv = (uu >> 2) & 1; t0 = (uu & 3) * 64; qrow0 = NLAT + b * LCTX + t0; }
        const int ilo = lat ? (t0 >= 128 ? 0 : (t0 >= 64 ? 1 : 2)) : 5, ihi = lat ? (t0 + 128 < LSEQ ? 4 : (t0 + 64 < LSEQ ? 3 : 2)) : 4;
        const int nloc = lat ? (ihi - ilo + 1) : 0;
        ntiles = nloc + 4; tfirst = ilo;
        const int head = kv * 4 + g;
        const int tq = t0 + qh * 32 + r;
        const bf16* qp = C.P + (size_t)(qrow0 + qh * 32 + r) * INW + CA_Q + head * 64;
        bf16x8 Qf[4];
#pragma unroll
        for (int s = 0; s < 4; ++s) Qf[s] = *(const bf16x8*)(qp + s * 16 + h * 8);
        f32x16 O[2];
#pragma unroll
        for (int mt = 0; mt < 2; ++mt)
#pragma unroll
            for (int i = 0; i < 16; ++i) O[mt][i] = 0.f;
        float ls = 0.f;
        v4u kreg, vreg, kreg2, vreg2;
        auto tile_row = [&](int it) -> int { return it < nloc ? b * LSEQ + t0 + 64 * (tfirst + it - 2) : NLAT + b * LCTX + 64 * (it - nloc); };
        { const bf16* kr = C.P + (size_t)(tile_row(0) + srow) * INW; kreg = *(const v4u*)(kr + CA_K + kv * 64 + sch * 8); vreg = *(const v4u*)(kr + CA_V + kv * 64 + sch * 8); }
        { const bf16* kr = C.P + (size_t)(tile_row(1) + srow) * INW; kreg2 = *(const v4u*)(kr + CA_K + kv * 64 + sch * 8); vreg2 = *(const v4u*)(kr + CA_V + kv * 64 + sch * 8); }
        __syncthreads();
        *(LAS v4u*)(lds + srow * KV_PITCH + sch * 16) = kreg; *(LAS v4u*)(lds + 2 * KV_IMG + srow * KV_PITCH + sch * 16) = vreg;
        kreg = kreg2; vreg = vreg2;
        __syncthreads();
        for (int it = 0; it < ntiles; ++it) {
            const int cur = it & 1;
            if (it + 2 < ntiles) { const bf16* kr = C.P + (size_t)(tile_row(it + 2) + srow) * INW; kreg2 = *(const v4u*)(kr + CA_K + kv * 64 + sch * 8); vreg2 = *(const v4u*)(kr + CA_V + kv * 64 + sch * 8); }
            LAS unsigned char* Kb = lds + cur * KV_IMG; LAS unsigned char* Vb = lds + 2 * KV_IMG + cur * KV_IMG;
            const bool local = it < nloc; const int tk0 = t0 + 64 * (tfirst + it - 2);
            const bool edge = local && (tfirst + it == 0 || tfirst + it == 4);
#pragma unroll
            for (int sub = 0; sub < 2; ++sub) {
                f32x16 S;
#pragma unroll
                for (int i = 0; i < 16; ++i) S[i] = -Mb2;
#pragma unroll
                for (int s = 0; s < 4; ++s) { const bf16x8 kf = *(LAS bf16x8*)(Kb + (32 * sub + r) * KV_PITCH + s * 32 + h * 16); S = MFMA32(kf, Qf[s], S); }
                float t = 0.f;
#pragma unroll
                for (int i = 0; i < 16; ++i) { float e = __builtin_amdgcn_exp2f(S[i]);
                    if (edge) { const int tk = tk0 + 32 * sub + (i & 3) + 8 * (i >> 2) + 4 * h; const int d = tq - tk; e = (d > 128 || d < -128) ? 0.f : e; }
                    S[i] = e; t += e; }
                ls += t;
                const bf16x8 P0 = PACK8(S, 0), P1 = PACK8(S, 1);
#pragma unroll
                for (int mt = 0; mt < 2; ++mt) {
                    const bf16x8 v0 = tr_pair(Vb + (32 * sub) * KV_PITCH + voff + mt * 64);
                    const bf16x8 v1 = tr_pair(Vb + (32 * sub + 16) * KV_PITCH + voff + mt * 64);
                    O[mt] = MFMA32(v0, P0, O[mt]); O[mt] = MFMA32(v1, P1, O[mt]);
                }
            }
            if (it + 1 < ntiles) { *(LAS v4u*)(lds + (cur ^ 1) * KV_IMG + srow * KV_PITCH + sch * 16) = kreg; *(LAS v4u*)(lds + 2 * KV_IMG + (cur ^ 1) * KV_IMG + srow * KV_PITCH + sch * 16) = vreg; kreg = kreg2; vreg = vreg2; }
            __syncthreads();
        }
        ls += shx_(C.lane, ls, 32);
        const float inv = 1.f / (ls + __builtin_amdgcn_exp2f(C.wsink[l * 8 + head] * 1.4426950408889634f - Mb2));
        bf16* op = C.MIX + (size_t)(qrow0 + qh * 32 + r) * 1024 + head * 64;
#pragma unroll
        for (int mt = 0; mt < 2; ++mt)
#pragma unroll
            for (int gg = 0; gg < 4; ++gg) { const int dv0 = 32 * mt + 8 * gg + 4 * h;
                v2u w; w.x = pkbf(O[mt][4 * gg] * inv, O[mt][4 * gg + 1] * inv); w.y = pkbf(O[mt][4 * gg + 2] * inv, O[mt][4 * gg + 3] * inv);
                *(v2u*)(op + dv0) = w; }
    }
}


constexpr size_t WS_DEC = 452 * MiB;
constexpr int HG_IMG = 64 * KV_PITCH;
DI bf16x8 tr_nat(LAS unsigned char* img, int rowbase, int colbase, int lane) {
    const int h = lane >> 5, q4 = (lane & 15) >> 2, p4 = lane & 3, grp = (lane >> 4) & 1;
    LAS unsigned char* p = img + (rowbase + 8 * h + q4) * KV_PITCH + (colbase + 16 * grp + 4 * p4) * 2;
    const s16x4 lo = __builtin_amdgcn_ds_read_tr16_b64_v4i16((LAS s16x4*)p), hi = __builtin_amdgcn_ds_read_tr16_b64_v4i16((LAS s16x4*)(p + 4 * KV_PITCH));
    return __builtin_shufflevector(lo, hi, 0, 1, 2, 3, 4, 5, 6, 7);
}
DI int hg_rowbase(int b, int tc) { return tc < 4 ? NLAT + b * LCTX + 64 * tc : b * LSEQ + 64 * (tc - 4); }
DI int hg_scan_n(int tc, int dir) { return tc < 4 ? (dir ? 3 - tc : tc) : (dir ? 4 + (131 - tc) : tc); }

template <int MODE> DI void hgrn_chunk_phase(const Args& A, int wave_s, int l, bool need_ctx, LAS unsigned char* lds) {
    const Ctx C = make_ctx(A, wave_s);
    const int lane = C.lane, wave = C.wave, dir = wave >> 2, iq = wave & 3, r = lane & 31, h5 = lane >> 5;
    float* DEC = (float*)(C.ws + WS_DEC);
    LAS float* qt = (LAS float*)(lds + 131072);
    LAS unsigned char* img = lds + dir * (5 * HG_IMG);
    LAS float* OX = (LAS float*)(lds + 10 * HG_IMG);
    const int ntc = (MODE == 0 || need_ctx) ? 132 : 128, tc0 = (MODE == 0 || need_ctx) ? 0 : 4;
    const int nunits = 16 * ntc;
    const int kp = lane & 31, e8 = (wave & 3) * 2 + (lane >> 5);
    unsigned npf[8], nv[8], nq[8], nsp[8];
#define HG_UNIT(uu, bh_, tc_, b_, hd_, rbase_, n_, seq_) const int bh_ = (uu) / ntc, tc_ = tc0 + (uu) % ntc, b_ = bh_ >> 2, hd_ = bh_ & 3; \
        const int rbase_ = hg_rowbase(b_, tc_), n_ = hg_scan_n(tc_, dir), seq_ = (dir * 4 + b_) * 4 + hd_;
#define HG_FETCH(uu) do { HG_UNIT(uu, fbh, ftc, fb, fhd, frb, fn, fseq) \
        const int fq_ = (dir ? CB_QB : CB_QF) + fhd * 64 + 2 * kp, ff_ = (dir ? CB_FB : CB_FF) + fhd * 64 + 2 * kp, fi_ = CB_I + fhd * 64 + 2 * kp; \
        _Pragma("unroll") for (int ii = 0; ii < 8; ++ii) { const int i = e8 * 8 + ii; const int row = dir ? frb + 63 - i : frb + i; const bf16* pr_ = C.P + (size_t)row * INW; \
            npf[ii] = *(const unsigned*)(pr_ + ff_); nv[ii] = *(const unsigned*)(pr_ + fi_); nq[ii] = (MODE == 1) ? *(const unsigned*)(pr_ + fq_) : 0u; } \
        if (MODE == 1) { const bf16* sl_ = (const bf16*)C.ST + ((size_t)(fseq * 132 + fn)) * 4096; _Pragma("unroll") for (int ii = 0; ii < 8; ++ii) nsp[ii] = *(const unsigned*)(sl_ + (e8 * 8 + ii) * 64 + 2 * kp); } } while (0)
    if ((int)blockIdx.x < nunits) HG_FETCH((int)blockIdx.x);
    for (int u = blockIdx.x; u < nunits; u += gridDim.x) {
        HG_UNIT(u, bh, tc, b, hd, rbase, n, seq)
        (void)bh; (void)b;
        const float lb0 = C.SM[SM_LOWER + (l * 2 + dir) * 256 + hd * 64 + 2 * kp], lb1 = C.SM[SM_LOWER + (l * 2 + dir) * 256 + hd * 64 + 2 * kp + 1];
        float cum0[8], cum1[8], kk0[8], kk1[8]; float bl0 = 0.f, bl1 = 0.f;
        unsigned vraw[8], qraw[8], spv[8];
#pragma unroll
        for (int ii = 0; ii < 8; ++ii) {
            const float pf0 = __builtin_bit_cast(float, npf[ii] << 16), pf1 = __builtin_bit_cast(float, npf[ii] & 0xffff0000u);
            const float f0 = fmaxf(lb0 + (1.f - lb0) * sigmoid_f(pf0), 1e-30f), f1 = fmaxf(lb1 + (1.f - lb1) * sigmoid_f(pf1), 1e-30f);
            bl0 += __logf(f0); bl1 += __logf(f1); cum0[ii] = bl0; cum1[ii] = bl1; kk0[ii] = 1.f - f0; kk1[ii] = 1.f - f1;
            vraw[ii] = nv[ii]; qraw[ii] = nq[ii]; spv[ii] = nsp[ii]; }
        bf16* SL = (bf16*)C.ST + ((size_t)(seq * 132 + n)) * 4096;
        if (u + (int)gridDim.x < nunits) HG_FETCH(u + (int)gridDim.x);
        __syncthreads();
        LAS fv2* qt2 = (LAS fv2*)qt;
        qt2[(dir * 8 + e8) * 32 + kp] = (fv2){bl0, bl1};
        __syncthreads();
        float off0 = 0.f, off1 = 0.f, bref0 = 0.f, bref1 = 0.f, bend0 = 0.f, bend1 = 0.f;
#pragma unroll
        for (int j = 0; j < 8; ++j) { const fv2 tq = qt2[(dir * 8 + j) * 32 + kp];
            if (j < e8) { off0 += tq.x; off1 += tq.y; }
            if (j < 4) { bref0 += tq.x; bref1 += tq.y; }
            bend0 += tq.x; bend1 += tq.y; }
#pragma unroll
        for (int ii = 0; ii < 8; ++ii) { const int i = e8 * 8 + ii; const float bi0 = off0 + cum0[ii], bi1 = off1 + cum1[ii];
            if (MODE == 0) {
                *(LAS unsigned*)(img + i * KV_PITCH + kp * 4) = pk2(kk0[ii] * __expf(bend0 - bi0), kk1[ii] * __expf(bend1 - bi1));
                *(LAS unsigned*)(img + HG_IMG + i * KV_PITCH + kp * 4) = vraw[ii];
            } else {
                const float q0 = __builtin_bit_cast(float, qraw[ii] << 16), q1 = __builtin_bit_cast(float, qraw[ii] & 0xffff0000u);
                *(LAS unsigned*)(img + i * KV_PITCH + kp * 4) = pk2(q0 * __expf(fminf(bi0 - bref0, 80.f)), q1 * __expf(fminf(bi1 - bref1, 80.f)));
                *(LAS unsigned*)(img + HG_IMG + i * KV_PITCH + kp * 4) = pk2(kk0[ii] * __expf(fminf(bref0 - bi0, 80.f)), kk1[ii] * __expf(fminf(bref1 - bi1, 80.f)));
                *(LAS unsigned*)(img + 2 * HG_IMG + i * KV_PITCH + kp * 4) = pk2(q0 * __expf(bi0), q1 * __expf(bi1));
                *(LAS unsigned*)(img + 3 * HG_IMG + i * KV_PITCH + kp * 4) = vraw[ii];
            }
        }
        if (MODE == 0) { if (e8 == 0) *(fv2*)(DEC + (seq * 132 + n) * 64 + 2 * kp) = (fv2){__expf(bend0), __expf(bend1)}; }
        else {
#pragma unroll
            for (int ii = 0; ii < 8; ++ii) { const int k = e8 * 8 + ii; *(LAS unsigned*)(img + 4 * HG_IMG + k * KV_PITCH + kp * 4) = spv[ii]; }
        }
        __syncthreads();
        if (MODE == 0) {
            const int kblk = (wave >> 1) & 1, dvblk = wave & 1;
            f32x16 S;
#pragma unroll
            for (int i = 0; i < 16; ++i) S[i] = 0.f;
#pragma unroll
            for (int is = 0; is < 4; ++is) { const bf16x8 a = tr_nat(img, 16 * is, 32 * kblk, lane), bb = tr_nat(img + HG_IMG, 16 * is, 32 * dvblk, lane); S = MFMA32(a, bb, S); }
#pragma unroll
            for (int i = 0; i < 16; ++i) { const int k = 32 * kblk + (i & 3) + 8 * (i >> 2) + 4 * h5; SL[k * 64 + 32 * dvblk + r] = (bf16)f2bf(S[i]); }
        } else {
            const int tblk = (wave >> 1) & 1, mt = wave & 1;
            LAS unsigned char* QP = img; LAS unsigned char* KP = img + HG_IMG; LAS unsigned char* QQ = img + 2 * HG_IMG; LAS unsigned char* VI = img + 3 * HG_IMG; LAS unsigned char* SP = img + 4 * HG_IMG;
            const int q4 = (lane & 15) >> 2, p4 = lane & 3, grp = (lane >> 4) & 1;
            const int voff = (4 * h5 + q4) * KV_PITCH + (16 * grp + 4 * p4) * 2;
            f32x16 O;
#pragma unroll
            for (int i = 0; i < 16; ++i) O[i] = 0.f;
#pragma unroll
            for (int sblk = 0; sblk < 2; ++sblk) {
                if (sblk <= tblk) {
                    f32x16 AT;
#pragma unroll
                    for (int i = 0; i < 16; ++i) AT[i] = 0.f;
#pragma unroll
                    for (int ks = 0; ks < 4; ++ks) { const bf16x8 a = *(LAS bf16x8*)(KP + (32 * sblk + r) * KV_PITCH + ks * 32 + h5 * 16), bq = *(LAS bf16x8*)(QP + (32 * tblk + r) * KV_PITCH + ks * 32 + h5 * 16); AT = MFMA32(a, bq, AT); }
                    if (sblk == tblk) {
#pragma unroll
                        for (int i = 0; i < 16; ++i) { const int sp = (i & 3) + 8 * (i >> 2) + 4 * h5; AT[i] = (sp <= r) ? AT[i] : 0.f; }
                    }
                    const bf16x8 P0 = PACK8(AT, 0), P1 = PACK8(AT, 1);
                    const bf16x8 v0 = tr_pair(VI + (32 * sblk) * KV_PITCH + voff + mt * 64), v1 = tr_pair(VI + (32 * sblk + 16) * KV_PITCH + voff + mt * 64);
                    O = MFMA32(v0, P0, O); O = MFMA32(v1, P1, O);
                }
            }
#pragma unroll
            for (int ks = 0; ks < 4; ++ks) { const bf16x8 a = tr_nat(SP, 16 * ks, 32 * mt, lane), bq = *(LAS bf16x8*)(QQ + (32 * tblk + r) * KV_PITCH + ks * 32 + h5 * 16); O = MFMA32(a, bq, O); }
            const int pos = 32 * tblk + r, tloc = dir ? 63 - pos : pos;
#pragma unroll
            for (int i = 0; i < 16; ++i) { const int dv = 32 * mt + (i & 3) + 8 * (i >> 2) + 4 * h5; OX[(dir * 64 + tloc) * 68 + dv] = O[i]; }
            __syncthreads();
            {
                const int t = C.tid >> 3, part = C.tid & 7; const int row = rbase + t;
                float tot[8]; float ss = 0.f;
#pragma unroll
                for (int e = 0; e < 8; ++e) { tot[e] = OX[t * 68 + part * 8 + e] + OX[(64 + t) * 68 + part * 8 + e]; ss += tot[e] * tot[e]; }
                ss += shx_(C.lane, ss, 1); ss += shx_(C.lane, ss, 2); ss += shx_(C.lane, ss, 4);
                const float rs = rsqrtf(ss * (1.f / 64.f) + EPS);
                const v4u gr = *(const v4u*)(C.P + (size_t)row * INW + CB_G + hd * 64 + part * 8);
                unsigned res[4];
#pragma unroll
                for (int q = 0; q < 4; ++q) { const float g0 = __builtin_bit_cast(float, gr[q] << 16), g1 = __builtin_bit_cast(float, gr[q] & 0xffff0000u);
                    const float y0 = tot[2 * q] * rs * C.hgog[l * 64 + part * 8 + 2 * q] * silu_f(g0), y1 = tot[2 * q + 1] * rs * C.hgog[l * 64 + part * 8 + 2 * q + 1] * silu_f(g1);
                    res[q] = pkbf(y0, y1); }
                v4u o; o.x = res[0]; o.y = res[1]; o.z = res[2]; o.w = res[3];
                *(v4u*)(C.MIX + (size_t)row * 1024 + 512 + hd * 64 + part * 8) = o;
            }
        }
    }
    __syncthreads();
}
DI void hgrn_scan_phase(const Args& A, int wave_s) {
    const Ctx C = make_ctx(A, wave_s);
    const float* DEC = (const float*)(C.ws + WS_DEC);
    for (int gid = blockIdx.x * 512 + C.tid; gid < 32 * 2048; gid += gridDim.x * 512) {
        const int seq = gid >> 11, e = gid & 2047, k = e >> 5;
        unsigned* SL = (unsigned*)C.ST + (size_t)seq * 132 * 2048 + e; const float* D = DEC + seq * 132 * 64 + k;
        float s0 = 0.f, s1 = 0.f;
        for (int n = 0; n < 132; n += 12) {
            unsigned sl[12]; float d[12];
#pragma unroll
            for (int j = 0; j < 12; ++j) { sl[j] = SL[(size_t)(n + j) * 2048]; d[j] = D[(n + j) * 64]; }
#pragma unroll
            for (int j = 0; j < 12; ++j) { SL[(size_t)(n + j) * 2048] = pk2(s0, s1);
                s0 = d[j] * s0 + __builtin_bit_cast(float, sl[j] << 16); s1 = d[j] * s1 + __builtin_bit_cast(float, sl[j] & 0xffff0000u); }
        }
    }
}

DI void conv_phase(const Args& A, int wave_s, int l, int j, int rows) {
    const Ctx C = make_ctx(A, wave_s);
    const float* cw = C.conv_w + (size_t)l * 3 * 5632; const float* cb = C.conv_b + (size_t)l * 5632;
    const int total = rows * 176;
    for (int e = blockIdx.x * 512 + C.tid; e < total; e += gridDim.x * 512) {
        const int m = e / 176, c8 = (e % 176) * 8;
        bool first, last;
        if (m < NLAT) { first = (m & 8191) == 0; last = (m & 8191) == 8191; } else { first = ((m - NLAT) & 255) == 0; last = ((m - NLAT) & 255) == 255; }
        const bf16* u1 = C.U + (size_t)m * DFF;
        v4u z = {0u, 0u, 0u, 0u};
        const v4u a0 = first ? z : *(const v4u*)(u1 - DFF + c8), a1 = *(const v4u*)(u1 + c8), a2 = last ? z : *(const v4u*)(u1 + DFF + c8);
        const v4u b0 = first ? z : *(const v4u*)(u1 - DFF + DFFH + c8), b1 = *(const v4u*)(u1 + DFFH + c8), b2 = last ? z : *(const v4u*)(u1 + DFF + DFFH + c8);
        const int na = j * DFFH + c8, nv = DFF + j * DFFH + c8;
        unsigned res[4];
#pragma unroll
        for (int q = 0; q < 4; ++q) {
            float r2[2];
#pragma unroll
            for (int hlf = 0; hlf < 2; ++hlf) {
                const int i = 2 * q + hlf;
                const float ua0 = hlf ? __builtin_bit_cast(float, a0[q] & 0xffff0000u) : __builtin_bit_cast(float, a0[q] << 16);
                const float ua1 = hlf ? __builtin_bit_cast(float, a1[q] & 0xffff0000u) : __builtin_bit_cast(float, a1[q] << 16);
                const float ua2 = hlf ? __builtin_bit_cast(float, a2[q] & 0xffff0000u) : __builtin_bit_cast(float, a2[q] << 16);
                const float ub0 = hlf ? __builtin_bit_cast(float, b0[q] & 0xffff0000u) : __builtin_bit_cast(float, b0[q] << 16);
                const float ub1 = hlf ? __builtin_bit_cast(float, b1[q] & 0xffff0000u) : __builtin_bit_cast(float, b1[q] << 16);
                const float ub2 = hlf ? __builtin_bit_cast(float, b2[q] & 0xffff0000u) : __builtin_bit_cast(float, b2[q] << 16);
                const float ya = cb[na + i] + ua0 * cw[na + i] + ua1 * cw[5632 + na + i] + ua2 * cw[2 * 5632 + na + i];
                const float yv = cb[nv + i] + ub0 * cw[nv + i] + ub1 * cw[5632 + nv + i] + ub2 * cw[2 * 5632 + nv + i];
                r2[hlf] = silu_f(ya) * yv;
            }
            res[q] = pk2(r2[0], r2[1]);
        }
        v4u o; o.x = res[0]; o.y = res[1]; o.z = res[2]; o.w = res[3];
        *(v4u*)(C.ACT + (size_t)m * DFFH + c8) = o;
    }
}


DI void ffn_fixup_phase(const Args& A, int wave_s, int l, int rows) {
    const Ctx C = make_ctx(A, wave_s);
    const float* cw = C.conv_w + (size_t)l * 3 * 5632; const float* cb = C.conv_b + (size_t)l * 5632;
    const bf16* UB = C.ACT;
    bf16* ACTF = C.U;
    const int nkb = rows / 64, total = nkb * 2 * 352;
    for (int e = blockIdx.x * 512 + C.tid; e < total; e += gridDim.x * 512) {
        const int c8 = (e % 352) * 8, rs = e / 352, side = rs & 1, kb = rs >> 1;
        const int R = kb * 64 + (side ? 63 : 0);
        bool first, last;
        if (R < NLAT) { first = (R & 8191) == 0; last = (R & 8191) == 8191; } else { first = ((R - NLAT) & 255) == 0; last = ((R - NLAT) & 255) == 255; }
        const v4u z = {0u, 0u, 0u, 0u};
        const bf16* pp = side ? UB + (size_t)((kb * 4 + 2) * 2) * 2816 : UB + (size_t)(((kb - 1) * 4 + 3) * 2) * 2816;
        const bf16* pc = UB + (size_t)((kb * 4 + (side ? 3 : 0)) * 2) * 2816;
        const bf16* pn = side ? UB + (size_t)(((kb + 1) * 4 + 0) * 2) * 2816 : UB + (size_t)((kb * 4 + 1) * 2) * 2816;
        const bool zp = (!side) && first, zn = side && last;
        const v4u a0 = zp ? z : *(const v4u*)(pp + c8), a1 = *(const v4u*)(pc + c8), a2 = zn ? z : *(const v4u*)(pn + c8);
        const v4u b0 = zp ? z : *(const v4u*)(pp + 2816 + c8), b1 = *(const v4u*)(pc + 2816 + c8), b2 = zn ? z : *(const v4u*)(pn + 2816 + c8);
        unsigned res[4];
#pragma unroll
        for (int q = 0; q < 4; ++q) {
            float r2[2];
#pragma unroll
            for (int hlf = 0; hlf < 2; ++hlf) {
                const int i = c8 + 2 * q + hlf;
                const float ua0 = hlf ? __builtin_bit_cast(float, a0[q] & 0xffff0000u) : __builtin_bit_cast(float, a0[q] << 16);
                const float ua1 = hlf ? __builtin_bit_cast(float, a1[q] & 0xffff0000u) : __builtin_bit_cast(float, a1[q] << 16);
                const float ua2 = hlf ? __builtin_bit_cast(float, a2[q] & 0xffff0000u) : __builtin_bit_cast(float, a2[q] << 16);
                const float ub0 = hlf ? __builtin_bit_cast(float, b0[q] & 0xffff0000u) : __builtin_bit_cast(float, b0[q] << 16);
                const float ub1 = hlf ? __builtin_bit_cast(float, b1[q] & 0xffff0000u) : __builtin_bit_cast(float, b1[q] << 16);
                const float ub2 = hlf ? __builtin_bit_cast(float, b2[q] & 0xffff0000u) : __builtin_bit_cast(float, b2[q] << 16);
                const float ya = cb[i] + ua0 * cw[i] + ua1 * cw[5632 + i] + ua2 * cw[2 * 5632 + i];
                const float yv = cb[2816 + i] + ub0 * cw[2816 + i] + ub1 * cw[5632 + 2816 + i] + ub2 * cw[2 * 5632 + 2816 + i];
                r2[hlf] = silu_f(ya) * yv;
            }
            res[q] = pk2(r2[0], r2[1]);
        }
        v4u o; o.x = res[0]; o.y = res[1]; o.z = res[2]; o.w = res[3];
        *(v4u*)(ACTF + (size_t)R * 2816 + c8) = o;
    }
}

typedef __attribute__((address_space(1))) unsigned gu32;
#define RLX_AGENT __ATOMIC_RELAXED, __HIP_MEMORY_SCOPE_AGENT
#define LDS_WAIT() asm volatile("s_waitcnt lgkmcnt(0)" ::: "memory")
#define VM_WAIT() asm volatile("s_waitcnt vmcnt(0)" ::: "memory")
#define XB_TMO      128
#define XB_XCNT(j)  (256  + 64 * (j))
#define XB_XSUB(j)  (1280 + 64 * (j))
#define XB_XGEN(j)  (2304 + 64 * (j))
#define XB_TOP      3328
#define XB_TOPGEN   3392
#define XCD_BAR_WORDS 3456
#define XB_SPIN_CAP (1u << 18)

__device__ __forceinline__ unsigned xb_ld(unsigned* p)              { return __hip_atomic_load(p, __ATOMIC_RELAXED, __HIP_MEMORY_SCOPE_AGENT); }
__device__ __forceinline__ unsigned xb_add(unsigned* p, unsigned v) { return __hip_atomic_fetch_add(p, v, __ATOMIC_RELAXED, __HIP_MEMORY_SCOPE_AGENT); }
__device__ __forceinline__ unsigned xb_xcc_id() { return (unsigned)__builtin_amdgcn_s_getreg((3 << 11) | 20) & 0xFu; }
#define XB_SPIN(cond, bar) do { unsigned _sp = 0; while (cond) { __builtin_amdgcn_s_sleep(1); \
    if ((++_sp & 255u) == 0u) { if (xb_ld(&(bar)[XB_TMO])) break; if (_sp > XB_SPIN_CAP) { atomicAdd(&(bar)[XB_TMO], 1u); break; } } } } while (0)

struct XcdBarrier {
    unsigned* bar; unsigned x;
    volatile LAS unsigned* st;
};

__device__ __forceinline__ XcdBarrier xcd_barrier_post(unsigned* bar, volatile LAS unsigned* st, int xtid) {
    XcdBarrier b; b.bar = bar; b.x = xb_xcc_id(); b.st = st;
    if (xtid == 0) (void)xb_add(&bar[XB_XCNT(b.x)], 1u);
    return b;
}
__device__ __forceinline__ void xcd_barrier_complete(unsigned* bar, unsigned x, unsigned& nloc, unsigned& nx) {
    const unsigned G = gridDim.x * gridDim.y * gridDim.z;
    unsigned sum, cnt, mine, sp = 0u;
    for (;;) {
        sum = 0u; cnt = 0u; mine = 0u;
#pragma unroll
        for (unsigned j = 0; j < 16; ++j) { const unsigned c = xb_ld(&bar[XB_XCNT(j)]); sum += c; cnt += (c > 0u) ? 1u : 0u; mine = (j == x) ? c : mine; }
        if (sum == G) break;
        __builtin_amdgcn_s_sleep(1);
        if ((++sp & 255u) == 0u) { if (xb_ld(&bar[XB_TMO])) break; if (sp > XB_SPIN_CAP) { atomicAdd(&bar[XB_TMO], 1u); break; } }
    }
    nloc = mine > 0u ? mine : 1u; nx = cnt > 0u ? cnt : 1u;
}

__device__ __forceinline__ void xcd_barrier(const XcdBarrier& b, int xtid) {
    asm volatile("s_waitcnt vmcnt(0)" ::: "memory");
    __syncthreads();
    if (xtid == 0) {
        unsigned* bar = b.bar; unsigned bx_ = b.x; asm volatile("" : "+s"(bx_));
        __builtin_amdgcn_s_waitcnt(0);
        unsigned nloc = b.st[0], nx = b.st[1];
        if (nloc == 0u) { xcd_barrier_complete(bar, bx_, nloc, nx); b.st[0] = nloc; b.st[1] = nx; }
        const unsigned old = xb_add(&bar[XB_XSUB(bx_)], 1u);
        const unsigned gen = old / nloc;
        if (old + 1u == (gen + 1u) * nloc) {
            __builtin_amdgcn_fence(__ATOMIC_RELEASE, "agent");
            asm volatile("s_waitcnt vmcnt(0)" ::: "memory");
            const unsigned og = xb_add(&bar[XB_TOP], 1u);
            const unsigned tg = og / nx;
            if (og + 1u == (tg + 1u) * nx) xb_add(&bar[XB_TOPGEN], 1u);
            else XB_SPIN(xb_ld(&bar[XB_TOPGEN]) == tg, bar);
            __builtin_amdgcn_fence(__ATOMIC_ACQUIRE, "agent");
            xb_add(&bar[XB_XGEN(bx_)], 1u);
            asm volatile("s_waitcnt vmcnt(0)" ::: "memory");
        } else {
            XB_SPIN(xb_ld(&bar[XB_XGEN(bx_)]) == gen, bar);
            __builtin_amdgcn_fence(__ATOMIC_ACQUIRE, "agent");
            asm volatile("s_waitcnt vmcnt(0)" ::: "memory");
        }
    }
    __syncthreads();
}

#if PROBE_SYNC2
#define GSYNC() do { xcd_barrier(xbar, wave_s * 64 + fresh_lane()); xcd_barrier(xbar, wave_s * 64 + fresh_lane()); } while (0)
#else
#define GSYNC() xcd_barrier(xbar, wave_s * 64 + fresh_lane())
#endif
__global__ void __launch_bounds__(512, 2) fwd_kernel(Args args) {
    extern __shared__ __attribute__((aligned(16))) unsigned char lds_raw[];
    LAS unsigned char* lds = (LAS unsigned char*)lds_raw;
    cg::grid_group grid = cg::this_grid();
    const int G = gridDim.x, bx = blockIdx.x;

    if (threadIdx.x < 4) ((volatile LAS unsigned*)(lds + 139264))[threadIdx.x] = 0u;
    __syncthreads();
    const int wave_s = __builtin_amdgcn_readfirstlane(threadIdx.x >> 6);
    XcdBarrier xbar = xcd_barrier_post((unsigned*)args.ws + 1024, (volatile LAS unsigned*)(lds + 139264), (int)threadIdx.x);
    p0_phase(args, wave_s, lds);
    p0_transposes(args, wave_s, lds, 0, 1536, bx * 8 + wave_s, G * 8);
    grid.sync();
    for (int l = 0; l < 2; ++l) {
        const bool need_ctx = (l == 0);
        const int Mres = need_ctx ? MTOT : NLAT;
        norm_phase(args, wave_s, l, 1, MTOT);
#if PROBE_EW2
        norm_phase(args, wave_s, l, 1, MTOT);
#endif
        GSYNC();
        { pg8::Gemm g{(const bf16*)(args.ws + WS_H), (const bf16*)(args.ws + WS_WIN) + (size_t)l * 3072 * 1024, MTOT, INW, 1024}; pg8::StaticOrder S; S.init(MTOT, INW, G, bx);
          pg8::EpiBf16 E{(bf16*)(args.ws + WS_P), INW}; pg8::gemm_phase<pg8::EpiBf16, pg8::StaticOrder, true, true>(lds, g, S, E, wave_s * 64 + fresh_lane());
#if PROBE_IN2
          pg8::gemm_phase<pg8::EpiBf16, pg8::StaticOrder, true, true>(lds, g, S, E, wave_s * 64 + fresh_lane());
#endif
          if (l == 0 && bx >= (1584 % G)) p0_transposes(args, wave_s, lds, 1536, 12544, (bx - 1584 % G) * 8 + wave_s, (G - 1584 % G) * 8);
#if PROBE_GEMM2
          pg8::gemm_phase<pg8::EpiBf16, pg8::StaticOrder, true, true>(lds, g, S, E, wave_s * 64 + fresh_lane());
#endif
        }
        GSYNC();
        prep_phase(args, wave_s, l);
        hgrn_chunk_phase<0>(args, wave_s, l, need_ctx, lds);
        GSYNC();
        hgrn_scan_phase(args, wave_s);
        win_mfma_phase(args, wave_s, l, need_ctx, lds);
        GSYNC();
        hgrn_chunk_phase<1>(args, wave_s, l, need_ctx, lds);
        diff_mfma_phase(args, wave_s, l, need_ctx, lds);
        GSYNC();
        { pg8::Gemm g{(const bf16*)(args.ws + WS_MIX), (const bf16*)(args.ws + WS_WOUT) + (size_t)l * 1024 * 1024, Mres, 1024, 1024}; pg8::StaticOrder S; S.init(Mres, 1024, G, bx);
          pg8::EpiResGate E{l == 0 ? args.in[0] : args.out, l == 0 ? args.in[2] : (const float*)(args.ws + WS_XC), args.out, (float*)(args.ws + WS_XC), (const float*)(args.ws + WS_SMALL) + SM_MOD + l * 5 * 6144 + 2048};
          pg8::gemm_phase<pg8::EpiResGate, pg8::StaticOrder, true, true>(lds, g, S, E, wave_s * 64 + fresh_lane()); }
        GSYNC();
        norm_phase(args, wave_s, l, 2, Mres);
#if PROBE_EW2
        norm_phase(args, wave_s, l, 2, Mres);
#endif
        GSYNC();
        { pg8::Gemm g{(const bf16*)(args.ws + WS_H), (const bf16*)(args.ws + WS_WUP) + (size_t)l * 5632 * 1024, Mres, 5632, 1024}; pg8::StaticOrder S; S.init(Mres, 5632, G, bx);
          pg8::EpiConvGate E{(bf16*)(args.ws + WS_U), (bf16*)(args.ws + WS_ACT), args.in[20] + (size_t)l * 3 * 5632, args.in[21] + (size_t)l * 5632};
          pg8::gemm_phase<pg8::EpiConvGate, pg8::StaticOrder, true, true>(lds, g, S, E, wave_s * 64 + fresh_lane());
#if PROBE_UP2
          pg8::gemm_phase<pg8::EpiConvGate, pg8::StaticOrder, true, true>(lds, g, S, E, wave_s * 64 + fresh_lane());
#endif
        }
        GSYNC();
        ffn_fixup_phase(args, wave_s, l, Mres);
        GSYNC();
        { pg8::Gemm g{(const bf16*)(args.ws + WS_U), (const bf16*)(args.ws + WS_WDN) + (size_t)l * 2816 * 1024, Mres, 1024, DFF}; pg8::StaticOrder S; S.init(Mres, 1024, G, bx);
          pg8::EpiResGate E{args.out, (const float*)(args.ws + WS_XC), args.out, (float*)(args.ws + WS_XC), (const float*)(args.ws + WS_SMALL) + SM_MOD + l * 5 * 6144 + 5120};
          pg8::gemm_phase<pg8::EpiResGate, pg8::StaticOrder, true, true>(lds, g, S, E, wave_s * 64 + fresh_lane()); }
        if (l == 0) GSYNC();
    }
}

extern "C" void kernel_launch(void* const* d_in, const int* in_sizes, int n_in, void* d_out, int out_size, void* d_ws, size_t ws_size, hipStream_t stream) {
    static int grid = 0;
    if (grid == 0) {
        if (n_in != 23 || ws_size < WS_END) { fprintf(stderr, "kernel_launch: bad args n_in %d ws %zu\n", n_in, ws_size); grid = -1; return; }
        int dev = 0, cus = 0, per_cu = 0;
        (void)hipGetDevice(&dev); (void)hipDeviceGetAttribute(&cus, hipDeviceAttributeMultiprocessorCount, dev);
        (void)hipFuncSetAttribute((const void*)fwd_kernel, hipFuncAttributeMaxDynamicSharedMemorySize, LDS_BYTES);
        (void)hipOccupancyMaxActiveBlocksPerMultiprocessor(&per_cu, (const void*)fwd_kernel, 512, LDS_BYTES);
        if (per_cu < 1) per_cu = 1;
        grid = cus;
        (void)hipGetLastError();
    }
    if (grid < 0) return;
    if (hipMemsetAsync(d_ws, 0, 65536, stream) != hipSuccess) { fprintf(stderr, "memset failed\n"); return; }
    Args a{};
    for (int i = 0; i < 23; ++i) a.in[i] = (const float*)d_in[i];
    a.out = (float*)d_out; a.ws = (unsigned char*)d_ws;
    void* params[] = {&a};
    hipError_t e = hipLaunchCooperativeKernel((const void*)fwd_kernel, dim3(grid), dim3(512), params, LDS_BYTES, stream);
    if (e != hipSuccess) fprintf(stderr, "cooperative launch failed: %s (grid %d)\n", hipGetErrorString(e), grid);
}
```
